# Optimizing an MI355X kernel written in HIP

```python
import math
import jax, jax.numpy as jnp
from jax import lax
import numpy as np

D_MODEL = 1024
BATCH = 4
SEQ = 4096
DEPTH = 2
DEC_BATCH = 32
DEC_SEQ = 64
PAST_LEN = 4096

CHUNK = 64
Q_BLOCK = 128
N_AB_LAYERS = (DEPTH + 1) // 2
N_SB_LAYERS = DEPTH // 2
N_SUB = 3
DN_HEADS = 8
DN_DK = 64
DN_DV = 64
DN_WIDTH = DN_HEADS * DN_DK
DN_CONV = 4
SC_WIDTH = D_MODEL // 2
SC_CONV = 3
AB_PROJ = 3 * DN_WIDTH + DN_HEADS * DN_DV + 2 * DN_HEADS + 3 * SC_WIDTH
AB_OUT = DN_HEADS * DN_DV + SC_WIDTH
SB_HEADS = 16
SB_DH = D_MODEL // SB_HEADS
SB_WIDTH = SB_HEADS * SB_DH
D_FF = 2816
NORM_EPS = 1e-6

kernel_name = 'hybrid_gdn_shortconv_stickbreak_stream_step'


def _rmsnorm(x, g):
    xf = x.astype(jnp.float32)
    y = xf * lax.rsqrt(jnp.mean(xf * xf, axis=-1, keepdims=True) + NORM_EPS)
    return y * g.astype(jnp.float32)


def _modulated_norm(x, g, shift, scale):
    y = _rmsnorm(x, g) * (1.0 + scale[:, None].astype(jnp.float32)) + shift[:, None].astype(jnp.float32)
    return y.astype(x.dtype)


def _swiglu(h, w_in, w_out):
    gate, up = jnp.split(h @ w_in, 2, axis=-1)
    return (jax.nn.silu(gate) * up) @ w_out


def _l2norm(x):
    return x * lax.rsqrt(jnp.sum(x * x, axis=-1, keepdims=True) + 1e-6)


def _causal_dwconv(x, prev, w):
    width = w.shape[0]
    t = x.shape[1]
    xp = jnp.concatenate([prev.astype(x.dtype), x], axis=1)
    y = xp[:, 0:t] * w[0]
    for j in range(1, width):
        y = y + xp[:, j:j + t] * w[j]
    return y, xp[:, t:]


def _gdn_chunk(S, xs):
    q, k, v, g, beta = xs
    c = q.shape[2]
    incl = jnp.tril(jnp.ones((c, c), dtype=bool))
    strict = jnp.tril(jnp.ones((c, c), dtype=bool), k=-1)
    G = jnp.cumsum(g, axis=-1)
    decay = jnp.exp(jnp.where(incl, G[..., :, None] - G[..., None, :], -jnp.inf))
    a_mat = jnp.where(strict, beta[..., :, None] * jnp.einsum('bhtd,bhsd->bhts', k, k) * decay, 0.0)
    eye = jnp.eye(c, dtype=a_mat.dtype)
    rhs = jnp.concatenate([beta[..., None] * v, (beta * jnp.exp(G))[..., None] * k], axis=-1)
    sol = lax.linalg.triangular_solve(eye + a_mat, rhs, left_side=True, lower=True)
    dv = v.shape[-1]
    u = sol[..., :dv] - jnp.einsum('bhtk,bhkv->bhtv', sol[..., dv:], S)
    qk = jnp.einsum('bhtd,bhsd->bhts', q, k) * decay
    o = jnp.exp(G)[..., None] * jnp.einsum('bhtk,bhkv->bhtv', q, S) + jnp.einsum('bhts,bhsv->bhtv', qk, u)
    G_end = G[..., -1:]
    S_new = jnp.exp(G_end)[..., None] * S + jnp.einsum('bhtk,bhtv->bhkv', k * jnp.exp(G_end - G)[..., None], u)
    return S_new, o


def _gated_delta(q, k, v, g, beta, S0):
    b, h, t, _ = q.shape
    c = min(t, CHUNK)
    n = t // c

    def to_chunks(a):
        a = a.reshape((b, h, n, c) + a.shape[3:])
        return jnp.moveaxis(a, 2, 0)

    S, o = lax.scan(_gdn_chunk, S0, (to_chunks(q), to_chunks(k), to_chunks(v), to_chunks(g), to_chunks(beta)))
    o = jnp.moveaxis(o, 0, 2).reshape(b, h, t, -1)
    return o, S


def _ab_mixer(h, S0, conv_prev, sc_prev, w_in, w_conv, A_log, dt_bias, dn_g, w_sc, w_out):
    b, t, _ = h.shape
    f32 = jnp.float32
    splits = np.cumsum([3 * DN_WIDTH, DN_HEADS * DN_DV, DN_HEADS, DN_HEADS, SC_WIDTH, SC_WIDTH]).tolist()
    qkv, z, a, bt, sB, sC, sx = jnp.split(h @ w_in, splits, axis=-1)
    qkv, conv_state = _causal_dwconv(qkv, conv_prev, w_conv)
    qkv = jax.nn.silu(qkv).astype(f32)
    q, k, v = jnp.split(qkv, 3, axis=-1)

    def heads(x):
        return x.reshape(b, t, DN_HEADS, -1).transpose(0, 2, 1, 3)

    q = _l2norm(heads(q)) * DN_DK ** -0.5
    k = _l2norm(heads(k))
    v = heads(v)
    g = -jnp.exp(A_log.astype(f32)) * jax.nn.softplus(a.astype(f32) + dt_bias.astype(f32))
    beta = jax.nn.sigmoid(bt.astype(f32))
    o, S = _gated_delta(q, k, v, g.transpose(0, 2, 1), beta.transpose(0, 2, 1), S0.astype(f32))
    o = o.transpose(0, 2, 1, 3)
    o = _rmsnorm(o, dn_g) * jax.nn.silu(z.astype(f32).reshape(b, t, DN_HEADS, DN_DV))
    o = o.reshape(b, t, DN_HEADS * DN_DV).astype(h.dtype)
    yc, sc_state = _causal_dwconv(sC * sx, sc_prev, w_sc)
    y_sc = sB * yc
    y = jnp.concatenate([o, y_sc], axis=-1) @ w_out
    return y, S.astype(S0.dtype), conv_state, sc_state


def _sb_block(q, k, v, q_pos, k_pos):
    z = jnp.einsum('hqd,hkd->hqk', q.astype(jnp.float32), k.astype(jnp.float32)) * SB_DH ** -0.5
    visible = k_pos[None, :] < q_pos[:, None]
    log_rest = jnp.where(visible, -jax.nn.softplus(z), 0.0)
    later = lax.cumsum(log_rest, axis=2, reverse=True) - log_rest
    w = jnp.where(visible, jnp.exp(jax.nn.log_sigmoid(z) + later), 0.0)
    return jnp.einsum('hqk,hkd->hqd', w, v.astype(jnp.float32))


def _sb_mixer(h, ck, cv, w_qkv, w_out):
    b, t, _ = h.shape
    past = ck.shape[2]
    q, k, v = jnp.split(h @ w_qkv, 3, axis=-1)

    def heads(x):
        return x.reshape(b, t, SB_HEADS, SB_DH).transpose(0, 2, 1, 3)

    q, k, v = heads(q), heads(k), heads(v)
    k_all = jnp.concatenate([ck.astype(k.dtype), k], axis=2)
    v_all = jnp.concatenate([cv.astype(v.dtype), v], axis=2)
    outs = []
    for q0 in range(0, t, Q_BLOCK):
        q1 = min(q0 + Q_BLOCK, t)
        q_pos = past + jnp.arange(q0, q1)
        k_pos = jnp.arange(past + q1)
        ob = lax.map(lambda a: _sb_block(a[0], a[1], a[2], q_pos, k_pos),
                     (q[:, :, q0:q1], k_all[:, :, :past + q1], v_all[:, :, :past + q1]))
        outs.append(ob)
    o = jnp.concatenate(outs, axis=2).astype(h.dtype)
    y = o.transpose(0, 2, 1, 3).reshape(b, t, SB_WIDTH) @ w_out
    return y, k, v


def _trunk(x, c, s_delta, s_qkv, s_sc, ck, cv, norm_g, ada_w, ada_b, ff_w_in, ff_w_out,
           ab_w_in, ab_conv_qkv, dn_A_log, dn_dt_bias, dn_norm_g, sc_conv, ab_w_out,
           sb_w_qkv, sb_w_out, final_g):
    b = x.shape[0]
    new_delta, new_qkv, new_sc, new_k, new_v = [], [], [], [], []
    cond = jax.nn.silu(c)
    for l in range(DEPTH):
        mod = (cond @ ada_w[l] + ada_b[l]).reshape(b, N_SUB, 3, D_MODEL)
        shift, scale, gate = mod[:, :, 0], mod[:, :, 1], mod[:, :, 2]
        hh = _modulated_norm(x, norm_g[l, 0], shift[:, 0], scale[:, 0])
        x = x + 0.5 * gate[:, 0, None] * _swiglu(hh, ff_w_in[l, 0], ff_w_out[l, 0])
        hh = _modulated_norm(x, norm_g[l, 1], shift[:, 1], scale[:, 1])
        i = l // 2
        if l % 2 == 0:
            y, S, cq, cs = _ab_mixer(hh, s_delta[i], s_qkv[i], s_sc[i], ab_w_in[i], ab_conv_qkv[i],
                                     dn_A_log[i], dn_dt_bias[i], dn_norm_g[i], sc_conv[i], ab_w_out[i])
            new_delta.append(S)
            new_qkv.append(cq)
            new_sc.append(cs)
        else:
            y, kr, vr = _sb_mixer(hh, ck[i], cv[i], sb_w_qkv[i], sb_w_out[i])
            new_k.append(kr)
            new_v.append(vr)
        x = x + gate[:, 1, None] * y
        hh = _modulated_norm(x, norm_g[l, 2], shift[:, 2], scale[:, 2])
        x = x + 0.5 * gate[:, 2, None] * _swiglu(hh, ff_w_in[l, 1], ff_w_out[l, 1])
    y = _rmsnorm(x, final_g).astype(x.dtype)
    return y, jnp.stack(new_delta), jnp.stack(new_qkv), jnp.stack(new_sc), jnp.stack(new_k), jnp.stack(new_v)


def setup_inputs(seed: int = 0) -> dict:
    key = jax.random.key(seed)
    ks = jax.random.split(key, 24)
    f32 = jnp.float32

    def nrm(k, shape, s=1.0):
        return s * jax.random.normal(k, shape, f32)

    x_prompt = nrm(ks[0], (BATCH, SEQ, D_MODEL))
    x_sample = nrm(ks[1], (DEC_BATCH, DEC_SEQ, D_MODEL))
    c_prompt = nrm(ks[2], (BATCH, D_MODEL))
    c_sample = nrm(ks[3], (DEC_BATCH, D_MODEL))
    state_delta = nrm(ks[4], (N_AB_LAYERS, DEC_BATCH, DN_HEADS, DN_DK, DN_DV), 0.5)
    state_qkv_conv = nrm(ks[5], (N_AB_LAYERS, DEC_BATCH, DN_CONV - 1, 3 * DN_WIDTH))
    state_sconv = nrm(ks[6], (N_AB_LAYERS, DEC_BATCH, SC_CONV - 1, SC_WIDTH))
    cache_k = nrm(ks[7], (N_SB_LAYERS, DEC_BATCH, SB_HEADS, PAST_LEN, SB_DH))
    cache_v = nrm(ks[8], (N_SB_LAYERS, DEC_BATCH, SB_HEADS, PAST_LEN, SB_DH))
    norm_g = 1.0 + nrm(ks[9], (DEPTH, N_SUB, D_MODEL), 0.02)
    ada_w = nrm(ks[10], (DEPTH, D_MODEL, N_SUB * 3 * D_MODEL), 0.25 * D_MODEL ** -0.5)
    ada_b = nrm(ks[11], (DEPTH, N_SUB, 3, D_MODEL), 0.02).at[:, :, 2].add(1.0).reshape(DEPTH, N_SUB * 3 * D_MODEL)
    ff_w_in = nrm(ks[12], (DEPTH, 2, D_MODEL, 2 * D_FF), D_MODEL ** -0.5)
    ff_w_out = nrm(ks[13], (DEPTH, 2, D_FF, D_MODEL), D_FF ** -0.5)
    ab_w_in = nrm(ks[14], (N_AB_LAYERS, D_MODEL, AB_PROJ), D_MODEL ** -0.5)
    ab_conv_qkv = nrm(ks[15], (N_AB_LAYERS, DN_CONV, 3 * DN_WIDTH), DN_CONV ** -0.5)
    dn_A_log = jnp.log(jax.random.uniform(ks[16], (N_AB_LAYERS, DN_HEADS), f32, 1.0, 16.0))
    dt = jnp.exp(jax.random.uniform(ks[17], (N_AB_LAYERS, DN_HEADS), f32, math.log(1e-3), math.log(1e-1)))
    dn_dt_bias = dt + jnp.log(-jnp.expm1(-dt))
    dn_norm_g = 1.0 + nrm(ks[18], (N_AB_LAYERS, DN_DV), 0.02)
    sc_conv = nrm(ks[19], (N_AB_LAYERS, SC_CONV, SC_WIDTH), SC_CONV ** -0.5)
    ab_w_out = nrm(ks[20], (N_AB_LAYERS, AB_OUT, D_MODEL), AB_OUT ** -0.5)
    sb_w_qkv = nrm(ks[21], (N_SB_LAYERS, D_MODEL, 3 * SB_WIDTH), D_MODEL ** -0.5)
    sb_w_out = nrm(ks[22], (N_SB_LAYERS, SB_WIDTH, D_MODEL), SB_WIDTH ** -0.5)
    final_g = 1.0 + nrm(ks[23], (D_MODEL,), 0.02)
    return {'x_prompt': x_prompt, 'x_sample': x_sample, 'c_prompt': c_prompt, 'c_sample': c_sample,
            'state_delta': state_delta, 'state_qkv_conv': state_qkv_conv, 'state_sconv': state_sconv,
            'cache_k': cache_k, 'cache_v': cache_v, 'norm_g': norm_g, 'ada_w': ada_w, 'ada_b': ada_b,
            'ff_w_in': ff_w_in, 'ff_w_out': ff_w_out, 'ab_w_in': ab_w_in, 'ab_conv_qkv': ab_conv_qkv,
            'dn_A_log': dn_A_log, 'dn_dt_bias': dn_dt_bias, 'dn_norm_g': dn_norm_g, 'sc_conv': sc_conv,
            'ab_w_out': ab_w_out, 'sb_w_qkv': sb_w_qkv, 'sb_w_out': sb_w_out, 'final_g': final_g}


def reference(x_prompt, x_sample, c_prompt, c_sample, state_delta, state_qkv_conv, state_sconv,
              cache_k, cache_v, norm_g, ada_w, ada_b, ff_w_in, ff_w_out, ab_w_in, ab_conv_qkv,
              dn_A_log, dn_dt_bias, dn_norm_g, sc_conv, ab_w_out, sb_w_qkv, sb_w_out, final_g):
    bp = x_prompt.shape[0]
    dt_ = x_prompt.dtype
    p_delta0 = jnp.zeros((N_AB_LAYERS, bp, DN_HEADS, DN_DK, DN_DV), dt_)
    p_qkv0 = jnp.zeros((N_AB_LAYERS, bp, DN_CONV - 1, 3 * DN_WIDTH), dt_)
    p_sc0 = jnp.zeros((N_AB_LAYERS, bp, SC_CONV - 1, SC_WIDTH), dt_)
    p_kv0 = jnp.zeros((N_SB_LAYERS, bp, SB_HEADS, 0, SB_DH), dt_)
    y_prompt, p_delta, p_qkv, p_sc, p_k, p_v = _trunk(
        x_prompt, c_prompt, p_delta0, p_qkv0, p_sc0, p_kv0, p_kv0, norm_g, ada_w, ada_b, ff_w_in, ff_w_out,
        ab_w_in, ab_conv_qkv, dn_A_log, dn_dt_bias, dn_norm_g, sc_conv, ab_w_out, sb_w_qkv, sb_w_out, final_g)
    y_sample, s_delta, s_qkv, s_sc, s_k, s_v = _trunk(
        x_sample, c_sample, state_delta, state_qkv_conv, state_sconv, cache_k, cache_v, norm_g, ada_w, ada_b,
        ff_w_in, ff_w_out, ab_w_in, ab_conv_qkv, dn_A_log, dn_dt_bias, dn_norm_g, sc_conv, ab_w_out,
        sb_w_qkv, sb_w_out, final_g)
    return (y_prompt, y_sample, p_delta, p_qkv, p_sc, p_k, p_v, s_delta, s_qkv, s_sc, s_k, s_v)
```

```cpp
#include <hip/hip_runtime.h>
#include <cstdio>
#include <cstdint>

constexpr int D = 1024;
constexpr int NB_P = 4, SEQ = 4096, NB_S = 32, DSEQ = 64, PAST = 4096;
constexpr int MP = NB_P * SEQ, MS = NB_S * DSEQ, M = MP + MS;
constexpr int NBATCH = NB_P + NB_S;
constexpr int FF = 2816, FF2 = 5632, NMOD = 9216;
constexpr int ABN = 3840, PROJW = 3584;
constexpr int NH_DN = 8, NH_SB = 16;
constexpr float NORM_EPS = 1e-6f;
__host__ __device__ __forceinline__ int row_batch(int row) { return row < MP ? (row >> 12) : NB_P + ((row - MP) >> 6); }
namespace pg8 {
#define PG8_LAS __attribute__((address_space(3)))
typedef unsigned short bf16_t;
typedef short bf16x8 __attribute__((ext_vector_type(8)));
typedef float f32x4 __attribute__((ext_vector_type(4)));
typedef unsigned u32x4 __attribute__((ext_vector_type(4)));
constexpr int BM = 256, BK = 64, HALF = 128, HTB = HALF * BK * 2  , STAGE_BYTES = 8 * HTB, NXCD = 8, WGM = 8;

__host__ __device__ __forceinline__ int lds_byte(int r, int c) { const int st = (r >> 4) * 2 + (c >> 5), rr = r & 15, cc = c & 31, ob = rr * 64 + cc * 2; return st * 1024 + (ob ^ (((ob >> 9) & 1) << 5)); }
__host__ __device__ __forceinline__ void stage_rc(int b, int& R, int& C) { const int st = b / 1024, sb = b % 1024, swz = sb ^ (((sb >> 9) & 1) << 5); R = (st >> 1) * 16 + swz / 64; C = (st & 1) * 32 + (swz % 64) / 2; }
__host__ __device__ __forceinline__ int perm32(int rho) { const int n = rho >> 4, i = rho & 15; return 8 * (i >> 2) + 4 * n + (i & 3); }

struct Unit { int pm, pn; };
struct Gemm { const bf16_t* A; const bf16_t* Bt; int M, N, K; };

struct StaticOrder {
    int nM, nN, nwg, G, c;
    __host__ __device__ void init(int M, int N, int G_, int c_) { nM = M / BM; nN = N / BM; nwg = nM * nN; G = G_; c = c_; }
    __host__ __device__ bool next(int i, Unit& u) const {
        const long L = (long)i * G + c; if (L >= nwg) return false;
        int wgid = (int)L; { const int q = nwg / NXCD, r = nwg % NXCD, xcd = wgid % NXCD, off = wgid / NXCD; wgid = (xcd < r ? xcd * (q + 1) : r * (q + 1) + (xcd - r) * q) + off; }
        const int nig = WGM * nN, gid = wgid / nig, fm = gid * WGM, gsz = (nM - fm) < WGM ? (nM - fm) : WGM;
        u.pm = fm + ((wgid % nig) % gsz); u.pn = (wgid % nig) / gsz; return true;
    }
    __device__ __forceinline__ void a_ready(const Unit&) const {}
    __device__ __forceinline__ void done(const Unit&) const {}
};
__device__ __forceinline__ unsigned cvt_pk_bf16(float lo, float hi) { unsigned r; asm volatile("v_cvt_pk_bf16_f32 %0, %1, %2" : "=v"(r) : "v"(lo), "v"(hi)); return r; }
__device__ __forceinline__ float silu_f(float x) { return x * __builtin_amdgcn_rcpf(1.0f + __builtin_amdgcn_exp2f(-1.44269504089f * x)); }

struct EpiSwiglu {
    static constexpr bool PERM = true, AFTER_DRAIN = false;
    bf16_t* O;
    __device__ __forceinline__ void operator()(const f32x4 (&acc)[2][2][4][2], const Unit& u, int wr, int wc, int fr, int fq) const {
        const int row0 = u.pm * BM + wr * 64 + fr, col0 = u.pn * HALF + wc * 32 + 8 * fq;
#pragma unroll
        for (int ai = 0; ai < 2; ++ai)
#pragma unroll
            for (int m = 0; m < 4; ++m) {
                const f32x4 g0 = acc[ai][0][m][0], g1 = acc[ai][0][m][1], u0 = acc[ai][1][m][0], u1 = acc[ai][1][m][1];
                u32x4 w;
                w.x = cvt_pk_bf16(silu_f(g0[0]) * u0[0], silu_f(g0[1]) * u0[1]); w.y = cvt_pk_bf16(silu_f(g0[2]) * u0[2], silu_f(g0[3]) * u0[3]);
                w.z = cvt_pk_bf16(silu_f(g1[0]) * u1[0], silu_f(g1[1]) * u1[1]); w.w = cvt_pk_bf16(silu_f(g1[2]) * u1[2], silu_f(g1[3]) * u1[3]);
                *(u32x4*)(O + (size_t)(row0 + ai * HALF + m * 16) * FF + col0) = w; }
    }
};

struct EpiResid {
    static constexpr bool PERM = false, AFTER_DRAIN = false;
    const float* xin_p; const float* xin_s; float* xout; const float* gate; float coef;
    __device__ __forceinline__ void operator()(const f32x4 (&acc)[2][2][4][2], const Unit& u, int wr, int wc, int fr, int fq) const {
        const int col0 = u.pn * BM + wc * 32 + 4 * fq; const float* xin = u.pm < MP / BM ? xin_p : xin_s;
#pragma unroll
        for (int ai = 0; ai < 2; ++ai) {
            const int rbase = u.pm * BM + ai * HALF + wr * 64;
            const float* gp = gate + (size_t)row_batch(rbase) * NMOD + col0;
            f32x4 gv[2][2];
#pragma unroll
            for (int bj = 0; bj < 2; ++bj)
#pragma unroll
                for (int n = 0; n < 2; ++n) gv[bj][n] = *(const f32x4*)(gp + bj * HALF + n * 16) * coef;
#pragma unroll
            for (int m = 0; m < 4; ++m) { const size_t off = (size_t)(rbase + m * 16 + fr) * D + col0;
#pragma unroll
                for (int bj = 0; bj < 2; ++bj)
#pragma unroll
                    for (int n = 0; n < 2; ++n) { const f32x4 bs = *(const f32x4*)(xin + off + bj * HALF + n * 16); *(f32x4*)(xout + off + bj * HALF + n * 16) = bs + gv[bj][n] * acc[ai][bj][m][n]; }
                asm volatile("" ::: "memory"); }
        }
    }
};

struct EpiAB {
    static constexpr bool PERM = true, AFTER_DRAIN = false;
    bf16_t* P; float* abg;
    __device__ __forceinline__ void operator()(const f32x4 (&acc)[2][2][4][2], const Unit& u, int wr, int wc, int fr, int fq) const {
        const int row0 = u.pm * BM + wr * 64 + fr;
        if (u.pn < 14) {
            const int col0 = u.pn * BM + wc * 32 + 8 * fq;
#pragma unroll
            for (int ai = 0; ai < 2; ++ai)
#pragma unroll
                for (int m = 0; m < 4; ++m) { bf16_t* rowp = P + (size_t)(row0 + ai * HALF + m * 16) * PROJW + col0;
#pragma unroll
                    for (int bj = 0; bj < 2; ++bj) { const f32x4 v0 = acc[ai][bj][m][0], v1 = acc[ai][bj][m][1];
                        u32x4 w; w.x = cvt_pk_bf16(v0[0], v0[1]); w.y = cvt_pk_bf16(v0[2], v0[3]); w.z = cvt_pk_bf16(v1[0], v1[1]); w.w = cvt_pk_bf16(v1[2], v1[3]);
                        *(u32x4*)(rowp + bj * HALF) = w; } }
        } else if (wc == 0 && fq < 2) {
#pragma unroll
            for (int ai = 0; ai < 2; ++ai)
#pragma unroll
                for (int m = 0; m < 4; ++m) { float* rowp = abg + (size_t)(row0 + ai * HALF + m * 16) * 16 + 8 * fq;
                    *(f32x4*)(rowp) = acc[ai][0][m][0]; *(f32x4*)(rowp + 4) = acc[ai][0][m][1]; }
        }
    }
};

struct EpiQKV {
    static constexpr bool PERM = true, AFTER_DRAIN = false;
    bf16_t* Q; size_t qkv_stride; float* pk; float* sk; size_t pv_off, sv_off;
    __device__ __forceinline__ void operator()(const f32x4 (&acc)[2][2][4][2], const Unit& u, int wr, int wc, int fr, int fq) const {
        const int which = u.pn >> 2;
        bf16_t* dst = Q + (size_t)which * qkv_stride;
        const float sc = which == 0 ? 0.125f : 1.0f;
        const int ct0 = (u.pn & 3) * BM + wc * 32 + 8 * fq;
        const bool prm = u.pm < MP / BM;
        float* fbase = (prm ? pk : sk) + (which == 2 ? (prm ? pv_off : sv_off) : (size_t)0);
        const size_t hstride = (size_t)(prm ? SEQ : DSEQ) * 64;
#pragma unroll
        for (int ai = 0; ai < 2; ++ai)
#pragma unroll
            for (int m = 0; m < 4; ++m) {
                const int row = u.pm * BM + ai * HALF + wr * 64 + m * 16 + fr;
                const int rs = prm ? row : row - MP;
                float* f32row = fbase + (prm ? ((size_t)(rs >> 12) * NH_SB * SEQ + (rs & (SEQ - 1))) : ((size_t)(rs >> 6) * NH_SB * DSEQ + (rs & (DSEQ - 1)))) * 64;
#pragma unroll
                for (int bj = 0; bj < 2; ++bj) { const f32x4 v0 = acc[ai][bj][m][0] * sc, v1 = acc[ai][bj][m][1] * sc; const int ct = ct0 + bj * HALF;
                    u32x4 w; w.x = cvt_pk_bf16(v0[0], v0[1]); w.y = cvt_pk_bf16(v0[2], v0[3]); w.z = cvt_pk_bf16(v1[0], v1[1]); w.w = cvt_pk_bf16(v1[2], v1[3]);
                    *(u32x4*)(dst + (size_t)row * D + ct) = w;
                    if (which) { float* p = f32row + (size_t)(ct >> 6) * hstride + (ct & 63); *(f32x4*)p = v0; *(f32x4*)(p + 4) = v1; } } }
    }
};
template <class Epi, class Sched, bool ALIGN_EPI = false, bool SP2 = false>
__device__ __forceinline__ void gemm_phase(PG8_LAS unsigned char* lds, const Gemm g, const Sched& S, const Epi& E) {
    const int tid = threadIdx.x, wid = __builtin_amdgcn_readfirstlane(tid >> 6), lane = tid & 63, wr = wid >> 2, wc = wid & 3, fr = lane & 15, fq = lane >> 4;
    const int K = g.K, nt = K / BK;
    unsigned voffA[2], voffB[2];
#pragma unroll
    for (int i = 0; i < 2; ++i) { int R, C; stage_rc(tid * 16 + i * 8192, R, C); const int Rb = Epi::PERM ? ((R & ~31) + perm32(R & 31)) : R;
        voffA[i] = (unsigned)(R * K + C) * 2u; voffB[i] = (unsigned)(Rb * K + C) * 2u; }
    const size_t kstep = (size_t)(BK * 2);
    const size_t hstep = (size_t)HALF * K * 2;
    const size_t tstep = 2 * hstep;
    const unsigned ldsw = (unsigned)wid * 1024u;
    const int aoff = lds_byte(wr * 64 + fr, fq * 8), boff = lds_byte(wc * 32 + fr, fq * 8);
#define PG8_SA(b, h) (((b) * 2 + (h)) * HTB)
#define PG8_SB(b, h) ((4 + (b) * 2 + (h)) * HTB)
#define PG8_STAGE(bufoff, gbase, voff) do { _Pragma("unroll") for (int _i = 0; _i < 2; ++_i) \
        __builtin_amdgcn_global_load_lds((const unsigned*)((const char*)(gbase) + (voff)[_i]), (PG8_LAS unsigned*)(lds + (bufoff) + ldsw + _i * 8192), 16, 0, 0); } while (0)
#define PG8_LDA(dst, b, h) do { _Pragma("unroll") for (int m = 0; m < 4; ++m) _Pragma("unroll") for (int k = 0; k < 2; ++k) dst[m][k] = *(const PG8_LAS bf16x8*)(lds + PG8_SA(b, h) + aoff + m * 2048 + k * 1024); } while (0)
#define PG8_LDB(dst, b, h) do { _Pragma("unroll") for (int n = 0; n < 2; ++n) _Pragma("unroll") for (int k = 0; k < 2; ++k) dst[n][k] = *(const PG8_LAS bf16x8*)(lds + PG8_SB(b, h) + boff + n * 2048 + k * 1024); } while (0)
#define PG8_MMA(ai, bj, At, Bt) do { __builtin_amdgcn_s_setprio(1); _Pragma("unroll") for (int m = 0; m < 4; ++m) _Pragma("unroll") for (int n = 0; n < 2; ++n) _Pragma("unroll") for (int k = 0; k < 2; ++k) \
        acc[ai][bj][m][n] = __builtin_amdgcn_mfma_f32_16x16x32_bf16(Bt[n][k], At[m][k], acc[ai][bj][m][n], 0, 0, 0); __builtin_amdgcn_s_setprio(0); } while (0)
#define PG8_WAIT_V(n) asm volatile("s_waitcnt vmcnt(" #n ")" ::: "memory")
#define PG8_WAIT_L(n) asm volatile("s_waitcnt lgkmcnt(" #n ")" ::: "memory")
#define PG8_BAR __builtin_amdgcn_s_barrier()
#define PG8_SCHED __builtin_amdgcn_sched_barrier(0)
    Unit cur, nxt; int ui = 0;
    if (!S.next(0, cur)) return;
    f32x4 acc[2][2][4][2];
#pragma unroll
    for (int a = 0; a < 2; ++a)
#pragma unroll
        for (int b = 0; b < 2; ++b)
#pragma unroll
            for (int m = 0; m < 4; ++m)
#pragma unroll
                for (int n = 0; n < 2; ++n) acc[a][b][m][n] = (f32x4){0.f, 0.f, 0.f, 0.f};
    bf16x8 At[4][2], B0[2][2], B1[2][2];
    const char* cA = (const char*)g.A + (size_t)cur.pm * tstep; const char* cB = (const char*)g.Bt + (size_t)cur.pn * tstep;
    S.a_ready(cur);
    if constexpr (SP2) {
        PG8_STAGE(PG8_SB(0, 0), cB, voffB); PG8_STAGE(PG8_SB(0, 1), cB + hstep, voffB); PG8_STAGE(PG8_SA(0, 0), cA, voffA); PG8_STAGE(PG8_SA(0, 1), cA + hstep, voffA);
        if (wr == 1) PG8_BAR;
        PG8_WAIT_V(2); PG8_BAR;
        PG8_STAGE(PG8_SB(1, 0), cB + kstep, voffB); PG8_STAGE(PG8_SA(1, 0), cA + kstep, voffA); PG8_STAGE(PG8_SB(1, 1), cB + hstep + kstep, voffB);
        PG8_WAIT_V(6); PG8_BAR;
    } else {
        PG8_STAGE(PG8_SB(0, 0), cB, voffB); PG8_STAGE(PG8_SA(0, 0), cA, voffA); PG8_STAGE(PG8_SB(0, 1), cB + hstep, voffB); PG8_STAGE(PG8_SA(0, 1), cA + hstep, voffA);
        if (wr == 1) PG8_BAR;
        PG8_WAIT_V(4); PG8_BAR;
        PG8_STAGE(PG8_SB(1, 0), cB + kstep, voffB); PG8_STAGE(PG8_SA(1, 0), cA + kstep, voffA); PG8_STAGE(PG8_SB(1, 1), cB + hstep + kstep, voffB);
        PG8_WAIT_V(6); PG8_BAR;
    }
    for (;;) {
        const bool has_next = S.next(ui + 1, nxt);
        const char* nA = has_next ? (const char*)g.A + (size_t)nxt.pm * tstep : cA; const char* nB = has_next ? (const char*)g.Bt + (size_t)nxt.pn * tstep : cB;
        for (int t = 0; t < nt; t += 2) {
            const bool last = (t == nt - 2);
            const char* a1 = cA + (size_t)(t + 1) * kstep;
            const char* a2 = last ? nA : cA + (size_t)(t + 2) * kstep; const char* b2 = last ? nB : cB + (size_t)(t + 2) * kstep;
            const char* a3 = a2 + kstep; const char* b3 = b2 + kstep;
            if (last && has_next) S.a_ready(nxt);
            if constexpr (SP2) {
            PG8_LDB(B0, 0, 0); PG8_LDB(B1, 0, 1); PG8_SCHED; PG8_LDA(At, 0, 0); PG8_STAGE(PG8_SA(1, 1), a1 + hstep, voffA);
            PG8_WAIT_V(8); PG8_WAIT_L(0); PG8_BAR; PG8_MMA(0, 0, At, B0); PG8_MMA(0, 1, At, B1); PG8_BAR; PG8_SCHED;
            PG8_LDA(At, 0, 1); PG8_STAGE(PG8_SB(0, 0), b2, voffB); PG8_STAGE(PG8_SB(0, 1), b2 + hstep, voffB); PG8_STAGE(PG8_SA(0, 0), a2, voffA);
            PG8_WAIT_V(8); PG8_WAIT_L(0); PG8_BAR; PG8_MMA(1, 0, At, B0); PG8_MMA(1, 1, At, B1); PG8_BAR; PG8_SCHED;
            PG8_LDB(B0, 1, 0); PG8_LDB(B1, 1, 1); PG8_SCHED; PG8_LDA(At, 1, 0); PG8_STAGE(PG8_SA(0, 1), a2 + hstep, voffA);
            PG8_WAIT_V(8); PG8_WAIT_L(0); PG8_BAR; PG8_MMA(0, 0, At, B0); PG8_MMA(0, 1, At, B1); PG8_BAR; PG8_SCHED;
            PG8_LDA(At, 1, 1); PG8_STAGE(PG8_SB(1, 0), b3, voffB); PG8_STAGE(PG8_SB(1, 1), b3 + hstep, voffB); PG8_STAGE(PG8_SA(1, 0), a3, voffA);
            PG8_WAIT_V(8); PG8_WAIT_L(0); PG8_BAR; PG8_MMA(1, 0, At, B0); PG8_MMA(1, 1, At, B1); PG8_BAR; PG8_SCHED;
            } else {
            PG8_LDB(B0, 0, 0); PG8_SCHED; PG8_LDA(At, 0, 0); PG8_STAGE(PG8_SA(1, 1), a1 + hstep, voffA);
            PG8_WAIT_L(8); PG8_BAR; PG8_WAIT_L(0); PG8_MMA(0, 0, At, B0); PG8_BAR; PG8_SCHED;
            PG8_LDB(B1, 0, 1); PG8_STAGE(PG8_SB(0, 0), b2, voffB);
            PG8_BAR; PG8_WAIT_L(0); PG8_MMA(0, 1, At, B1); PG8_BAR;
            PG8_LDA(At, 0, 1); PG8_STAGE(PG8_SA(0, 0), a2, voffA);
            PG8_BAR; PG8_WAIT_L(0); PG8_MMA(1, 0, At, B0); PG8_BAR; PG8_SCHED;
            PG8_STAGE(PG8_SB(0, 1), b2 + hstep, voffB);
            PG8_WAIT_V(6); PG8_BAR; PG8_MMA(1, 1, At, B1); PG8_BAR;
            PG8_LDB(B0, 1, 0); PG8_SCHED; PG8_LDA(At, 1, 0); PG8_STAGE(PG8_SA(0, 1), a2 + hstep, voffA);
            PG8_WAIT_L(8); PG8_BAR; PG8_WAIT_L(0); PG8_MMA(0, 0, At, B0); PG8_BAR; PG8_SCHED;
            PG8_LDB(B1, 1, 1); PG8_STAGE(PG8_SB(1, 0), b3, voffB);
            PG8_BAR; PG8_WAIT_L(0); PG8_MMA(0, 1, At, B1); PG8_BAR;
            PG8_LDA(At, 1, 1); PG8_STAGE(PG8_SA(1, 0), a3, voffA);
            PG8_BAR; PG8_WAIT_L(0); PG8_MMA(1, 0, At, B0); PG8_BAR; PG8_SCHED;
            PG8_STAGE(PG8_SB(1, 1), b3 + hstep, voffB);
            PG8_WAIT_V(6); PG8_BAR; PG8_MMA(1, 1, At, B1); PG8_BAR;
            }
        }
        if constexpr (ALIGN_EPI) { if (wr == 0) PG8_BAR; }
        if constexpr (!Epi::AFTER_DRAIN) { E(acc, cur, wr, wc, fr, fq); S.done(cur); }
        if (!has_next) break;
#pragma unroll
        for (int a = 0; a < 2; ++a)
#pragma unroll
            for (int b = 0; b < 2; ++b)
#pragma unroll
                for (int m = 0; m < 4; ++m)
#pragma unroll
                    for (int n = 0; n < 2; ++n) acc[a][b][m][n] = (f32x4){0.f, 0.f, 0.f, 0.f};
        cur = nxt; cA = nA; cB = nB; ++ui;
        if constexpr (ALIGN_EPI) { if (wr == 1) PG8_BAR; }
    }
    PG8_WAIT_V(0);
    if constexpr (!ALIGN_EPI) { if (wr == 0) PG8_BAR; }
    PG8_BAR;
    if constexpr (Epi::AFTER_DRAIN) { E.fused(acc, cur, wr, wc, fr, fq, lds, wid, lane); S.done(cur); }
#undef PG8_SA
#undef PG8_SB
#undef PG8_STAGE
#undef PG8_LDA
#undef PG8_LDB
#undef PG8_MMA
#undef PG8_WAIT_V
#undef PG8_WAIT_L
#undef PG8_BAR
#undef PG8_SCHED
}
}
#define GAS __attribute__((address_space(1)))
#define LAS __attribute__((address_space(3)))
typedef unsigned short bf16;
typedef unsigned v4u __attribute__((ext_vector_type(4)));
typedef float f32x4 __attribute__((ext_vector_type(4)));
typedef short bf16x8 __attribute__((ext_vector_type(8)));
typedef GAS unsigned gu32;
typedef GAS unsigned long long gu64;
#define RLX_AGENT __ATOMIC_RELAXED, __HIP_MEMORY_SCOPE_AGENT
#define LDS_WAIT() asm volatile("s_waitcnt lgkmcnt(0)" ::: "memory")
#define VM_WAIT() asm volatile("s_waitcnt vmcnt(0)" ::: "memory")
__device__ __forceinline__ unsigned long long rt() { return __builtin_amdgcn_s_memrealtime(); }
__device__ __forceinline__ unsigned f2bf(float f) { unsigned u = __builtin_bit_cast(unsigned, f); return (u + 0x7fffu + ((u >> 16) & 1u)) >> 16; }
__device__ __forceinline__ unsigned pk2(float lo, float hi) { return f2bf(lo) | (f2bf(hi) << 16); }

#define XB_TMO      128
#define XB_XCNT(j)  (256  + 64 * (j))
#define XB_XSUB(j)  (1280 + 64 * (j))
#define XB_XGEN(j)  (2304 + 64 * (j))
#define XB_TOP      3328
#define XB_TOPGEN   3392
#define XCD_BAR_WORDS 3456
#define XB_SPIN_CAP (1u << 18)

__device__ __forceinline__ unsigned xb_ld(unsigned* p)              { return __hip_atomic_load(p, __ATOMIC_RELAXED, __HIP_MEMORY_SCOPE_AGENT); }
__device__ __forceinline__ unsigned xb_add(unsigned* p, unsigned v) { return __hip_atomic_fetch_add(p, v, __ATOMIC_RELAXED, __HIP_MEMORY_SCOPE_AGENT); }
__device__ __forceinline__ unsigned xb_xcc_id() { return (unsigned)__builtin_amdgcn_s_getreg((3 << 11) | 20) & 0xFu; }
#define XB_SPIN(cond, bar) do { unsigned _sp = 0; while (cond) { __builtin_amdgcn_s_sleep(1); \
    if ((++_sp & 255u) == 0u) { if (xb_ld(&(bar)[XB_TMO])) break; if (_sp > XB_SPIN_CAP) { atomicAdd(&(bar)[XB_TMO], 1u); break; } } } } while (0)

struct XcdBarrier {
    unsigned* bar; unsigned x;
    volatile LAS unsigned* st;
};

__device__ __forceinline__ XcdBarrier xcd_barrier_post(unsigned* bar, volatile LAS unsigned* st) {
    XcdBarrier b; b.bar = bar; b.x = xb_xcc_id(); b.st = st;
    if (threadIdx.x == 0) (void)xb_add(&bar[XB_XCNT(b.x)], 1u);
    return b;
}
__device__ __forceinline__ void xcd_barrier_complete(unsigned* bar, unsigned x, unsigned& nloc, unsigned& nx) {
    const unsigned G = gridDim.x * gridDim.y * gridDim.z;
    unsigned sum, cnt, mine, sp = 0u;
    for (;;) {
        sum = 0u; cnt = 0u; mine = 0u;
#pragma unroll
        for (unsigned j = 0; j < 16; ++j) { const unsigned c = xb_ld(&bar[XB_XCNT(j)]); sum += c; cnt += (c > 0u) ? 1u : 0u; mine = (j == x) ? c : mine; }
        if (sum == G) break;
        __builtin_amdgcn_s_sleep(1);
        if ((++sp & 255u) == 0u) { if (xb_ld(&bar[XB_TMO])) break; if (sp > XB_SPIN_CAP) { atomicAdd(&bar[XB_TMO], 1u); break; } }
    }
    nloc = mine > 0u ? mine : 1u; nx = cnt > 0u ? cnt : 1u;
}

__device__ __forceinline__ void xcd_barrier(const XcdBarrier& b) {
    asm volatile("s_waitcnt vmcnt(0)" ::: "memory");
    __syncthreads();
    if (threadIdx.x == 0) {
        unsigned* bar = b.bar;
        __builtin_amdgcn_s_waitcnt(0);
        unsigned nloc = b.st[0], nx = b.st[1];
        if (nloc == 0u) { xcd_barrier_complete(bar, b.x, nloc, nx); b.st[0] = nloc; b.st[1] = nx; }
        const unsigned old = xb_add(&bar[XB_XSUB(b.x)], 1u);
        const unsigned gen = old / nloc;
        if (old + 1u == (gen + 1u) * nloc) {
            __builtin_amdgcn_fence(__ATOMIC_RELEASE, "agent");
            asm volatile("s_waitcnt vmcnt(0)" ::: "memory");
            const unsigned og = xb_add(&bar[XB_TOP], 1u);
            const unsigned tg = og / nx;
            if (og + 1u == (tg + 1u) * nx) xb_add(&bar[XB_TOPGEN], 1u);
            else XB_SPIN(xb_ld(&bar[XB_TOPGEN]) == tg, bar);
            __builtin_amdgcn_fence(__ATOMIC_ACQUIRE, "agent");
            xb_add(&bar[XB_XGEN(b.x)], 1u);
            asm volatile("s_waitcnt vmcnt(0)" ::: "memory");
        } else {
            XB_SPIN(xb_ld(&bar[XB_XGEN(b.x)]) == gen, bar);
            __builtin_amdgcn_fence(__ATOMIC_ACQUIRE, "agent");
            asm volatile("s_waitcnt vmcnt(0)" ::: "memory");
        }
    }
    __syncthreads();
}

constexpr size_t MiB = 1u << 20;
constexpr size_t WS_CTL = 0, CTL_ZERO_BYTES = 1 * MiB;
constexpr size_t WS_MODS = 1 * MiB;
constexpr size_t WS_WFI = 4 * MiB;
constexpr size_t WS_WFO = 48 * MiB;
constexpr size_t WS_WABI = 70 * MiB;
constexpr size_t WS_WABO = 78 * MiB;
constexpr size_t WS_WQKV = 80 * MiB;
constexpr size_t WS_WSBO = 86 * MiB;
constexpr size_t WS_X = 88 * MiB;
constexpr size_t WS_HH = 160 * MiB;
constexpr size_t WS_ACT = 196 * MiB;
constexpr size_t WS_PROJ = 296 * MiB;
constexpr size_t WS_ABG = 422 * MiB;
constexpr size_t WS_CAT = 424 * MiB;
constexpr size_t WS_Q = 460 * MiB, WS_K = 496 * MiB, WS_V = 532 * MiB;
constexpr size_t WS_MCH = 568 * MiB, WS_MCL = 586 * MiB;
constexpr size_t WS_NC = 604 * MiB;
constexpr size_t WS_QE = 640 * MiB;
constexpr size_t WS_OL = 658 * MiB;
constexpr size_t WS_ST = 694 * MiB;
constexpr size_t WS_END = 710 * MiB;
constexpr int CW_TMO = 0, CW_BAR = 4096;

constexpr size_t O_YP = 0, O_YS = O_YP + (size_t)MP * D, O_PDELTA = O_YS + (size_t)MS * D, O_PQKV = O_PDELTA + (size_t)NB_P * 8 * 64 * 64,
                 O_PSC = O_PQKV + (size_t)NB_P * 3 * 1536, O_PK = O_PSC + (size_t)NB_P * 2 * 512, O_PV = O_PK + (size_t)NB_P * 16 * SEQ * 64,
                 O_SDELTA = O_PV + (size_t)NB_P * 16 * SEQ * 64, O_SQKV = O_SDELTA + (size_t)NB_S * 8 * 64 * 64, O_SSC = O_SQKV + (size_t)NB_S * 3 * 1536,
                 O_SK = O_SSC + (size_t)NB_S * 2 * 512, O_SV = O_SK + (size_t)NB_S * 16 * DSEQ * 64, O_END = O_SV + (size_t)NB_S * 16 * DSEQ * 64;

constexpr int RING_BYTES = 131072;
constexpr int MISC_OFF = 151552;
constexpr int LDS_BYTES = MISC_OFF + 512;
constexpr int NWAVES = 8;

typedef unsigned u32x2 __attribute__((ext_vector_type(2)));
typedef float f32x2_t __attribute__((ext_vector_type(2)));
typedef __bf16 bf16x2_t __attribute__((ext_vector_type(2)));
__device__ __forceinline__ unsigned cvtpk(float lo, float hi) { f32x2_t v = {lo, hi}; bf16x2_t b = __builtin_convertvector(v, bf16x2_t); return __builtin_bit_cast(unsigned, b); }
__device__ __forceinline__ float bflo(unsigned u) { return __builtin_bit_cast(float, u << 16); }
__device__ __forceinline__ float bfhi(unsigned u) { return __builtin_bit_cast(float, u & 0xffff0000u); }
__device__ __forceinline__ float fexp(float x) { return __builtin_amdgcn_exp2f(x * 1.44269504089f); }
__device__ __forceinline__ float flog(float x) { return __builtin_amdgcn_logf(x) * 0.69314718056f; }
__device__ __forceinline__ float silu(float x) { return x * __builtin_amdgcn_rcpf(1.0f + fexp(-x)); }
__device__ __forceinline__ float softplus(float x) { return fmaxf(x, 0.f) + flog(1.0f + fexp(-fabsf(x))); }
__device__ __forceinline__ float wave_sum(float v) {
#pragma unroll
    for (int o = 1; o < 64; o <<= 1) v += __shfl_xor(v, o);
    return v;
}

struct Frame {
    LAS unsigned char* lds;
    int tid, lane, wave, vcu, G;
    const float* in[24]; float* out; unsigned char* ws;
};

constexpr int COND_STRIDE = 2064;
__device__ __forceinline__ void p0_mods(Frame& F, const float* c_p, const float* c_s, const float* ada_w, const float* ada_b, float* mods) {
    LAS unsigned char* condl = F.lds;
    LAS float* red = (LAS float*)(F.lds + 48 * COND_STRIDE);
    for (int e = F.tid; e < 48 * 512; e += NWAVES * 64) { const int b = e >> 9, k2 = (e & 511) * 2; unsigned w = 0u;
        if (b < NBATCH) { const float* cp = b < NB_P ? c_p + (size_t)b * D : c_s + (size_t)(b - NB_P) * D; w = cvtpk(silu(cp[k2]), silu(cp[k2 + 1])); }
        *(LAS unsigned*)(condl + b * COND_STRIDE + k2 * 2) = w; }
    for (int e = F.tid; e < 48 * 64; e += NWAVES * 64) red[e] = 0.f;
    __syncthreads();
    const int r = F.lane & 15, kq = F.lane >> 4;
    for (int item = blockIdx.x; item < 2 * (NMOD / 64); item += F.G) {
        const int l = item / (NMOD / 64), n0 = (item % (NMOD / 64)) * 64;
        const float* W = ada_w + (size_t)l * D * NMOD;
        pg8::f32x4 acc[3][4];
#pragma unroll
        for (int a = 0; a < 3; ++a)
#pragma unroll
            for (int b = 0; b < 4; ++b) acc[a][b] = (pg8::f32x4){0.f, 0.f, 0.f, 0.f};
#pragma unroll
        for (int s = 0; s < 4; ++s) { const int k0 = F.wave * 128 + s * 32 + 8 * kq;
            pg8::bf16x8 af[3], bfr[4];
#pragma unroll
            for (int a = 0; a < 3; ++a) af[a] = *(const LAS pg8::bf16x8*)(condl + (16 * a + r) * COND_STRIDE + k0 * 2);
#pragma unroll
            for (int b = 0; b < 4; ++b) { const float* wp = W + (size_t)k0 * NMOD + n0 + 16 * b + r; v4u t;
                t.x = cvtpk(wp[0], wp[NMOD]); t.y = cvtpk(wp[2 * NMOD], wp[3 * NMOD]); t.z = cvtpk(wp[4 * NMOD], wp[5 * NMOD]); t.w = cvtpk(wp[6 * NMOD], wp[7 * NMOD]);
                bfr[b] = __builtin_bit_cast(pg8::bf16x8, t); }
#pragma unroll
            for (int a = 0; a < 3; ++a)
#pragma unroll
                for (int b = 0; b < 4; ++b) acc[a][b] = __builtin_amdgcn_mfma_f32_16x16x32_bf16(af[a], bfr[b], acc[a][b], 0, 0, 0);
        }
#pragma unroll
        for (int a = 0; a < 3; ++a)
#pragma unroll
            for (int b = 0; b < 4; ++b)
#pragma unroll
                for (int i = 0; i < 4; ++i) __hip_atomic_fetch_add(red + (16 * a + 4 * kq + i) * 64 + 16 * b + r, acc[a][b][i], __ATOMIC_RELAXED, __HIP_MEMORY_SCOPE_WORKGROUP);
        __syncthreads();
        for (int e = F.tid; e < NBATCH * 64; e += NWAVES * 64) { const int b = e >> 6, n = e & 63; mods[((size_t)l * NBATCH + b) * NMOD + n0 + n] = red[e] + ada_b[(size_t)l * NMOD + n0 + n]; }
        __syncthreads();
        for (int e = F.tid; e < 48 * 64; e += NWAVES * 64) red[e] = 0.f;
        __syncthreads();
    }
    __syncthreads();
}

__device__ __forceinline__ void p0_transpose_item(const float* W, int ldw, int K, bf16* WT, int dst_r0, int src_c0, int k0, LAS float* scr, int lane) {
#pragma unroll 8
    for (int i = 0; i < 32; ++i) { const int kk = 2 * i + (lane >> 5); scr[kk * 33 + (lane & 31)] = W[(size_t)(k0 + kk) * ldw + src_c0 + (lane & 31)]; }
    LDS_WAIT(); asm volatile("" ::: "memory");
    const int c = lane & 7;
#pragma unroll
    for (int j = 0; j < 4; ++j) { const int n = (lane >> 3) + 8 * j; const LAS float* s = scr + (8 * c) * 33 + n;
        v4u o; o.x = cvtpk(s[0 * 33], s[1 * 33]); o.y = cvtpk(s[2 * 33], s[3 * 33]); o.z = cvtpk(s[4 * 33], s[5 * 33]); o.w = cvtpk(s[6 * 33], s[7 * 33]);
        *(GAS v4u*)(WT + (size_t)(dst_r0 + n) * K + k0 + 8 * c) = o; }
    LDS_WAIT(); asm volatile("" ::: "memory");
}
__device__ __forceinline__ void p0_weights(Frame& F) {
    LAS float* scr = (LAS float*)(F.lds + F.wave * 8448);
    const int gw = F.vcu * NWAVES + F.wave, NGW = F.G * NWAVES;
    constexpr int I_FI = (D / 64) * (FF2 / 32), I_FO = (FF / 64) * (D / 32), I_ABI = (D / 64) * (ABN / 32), I_SQ = (D / 64) * (D / 32), I_QKV = (D / 64) * (3 * D / 32);
    constexpr int NITEMS = 4 * I_FI + 4 * I_FO + I_ABI + I_SQ + I_QKV + I_SQ;
    unsigned char* ws = F.ws;
    for (int it = gw; it < NITEMS; it += NGW) {
        int r = it;
        if (r < 4 * I_FI) { const int mat = r / I_FI; r -= mat * I_FI; const int kb = r / (FF2 / 32), nb = r % (FF2 / 32), n0 = 32 * nb, t = n0 >> 8, i0 = n0 & 255;
            const int src = i0 < 128 ? 128 * t + i0 : FF + 128 * t + (i0 - 128);
            p0_transpose_item(F.in[12] + (size_t)mat * D * FF2, FF2, D, (bf16*)(ws + WS_WFI) + (size_t)mat * FF2 * D, n0, src, 64 * kb, scr, F.lane); continue; }
        r -= 4 * I_FI;
        if (r < 4 * I_FO) { const int mat = r / I_FO; r -= mat * I_FO; const int kb = r / (D / 32), nb = r % (D / 32);
            p0_transpose_item(F.in[13] + (size_t)mat * FF * D, D, FF, (bf16*)(ws + WS_WFO) + (size_t)mat * D * FF, 32 * nb, 32 * nb, 64 * kb, scr, F.lane); continue; }
        r -= 4 * I_FO;
        if (r < I_ABI) { const int kb = r / (ABN / 32), nb = r % (ABN / 32), n0 = 32 * nb; const int src = n0 < 2048 ? n0 : (n0 < PROJW ? n0 + 16 : 2048);
            p0_transpose_item(F.in[14], 3600, D, (bf16*)(ws + WS_WABI), n0, src, 64 * kb, scr, F.lane); continue; }
        r -= I_ABI;
        if (r < I_SQ) { const int kb = r / (D / 32), nb = r % (D / 32); p0_transpose_item(F.in[20], D, D, (bf16*)(ws + WS_WABO), 32 * nb, 32 * nb, 64 * kb, scr, F.lane); continue; }
        r -= I_SQ;
        if (r < I_QKV) { const int kb = r / (3 * D / 32), nb = r % (3 * D / 32); p0_transpose_item(F.in[21], 3 * D, D, (bf16*)(ws + WS_WQKV), 32 * nb, 32 * nb, 64 * kb, scr, F.lane); continue; }
        r -= I_QKV;
        { const int kb = r / (D / 32), nb = r % (D / 32); p0_transpose_item(F.in[22], D, D, (bf16*)(ws + WS_WSBO), 32 * nb, 32 * nb, 64 * kb, scr, F.lane); }
    }
}

__device__ __forceinline__ void norm_phase(Frame& F, const float* xa, const float* xb  , bf16* out, const float* g, const float* mod, int sub) {
    const int gw = F.vcu * NWAVES + F.wave, NGW = F.G * NWAVES, per = (M + NGW - 1) / NGW;
    const int r_lo = gw * per, r_hi = (r_lo + per < M) ? r_lo + per : M;
    int curb = -1; f32x4 gs[4], sh[4];
#pragma unroll
    for (int j = 0; j < 4; ++j) { gs[j] = (f32x4){0.f, 0.f, 0.f, 0.f}; sh[j] = gs[j]; }
    for (int row = r_lo; row < r_hi; ++row) {
        const int b = row_batch(row);
        if (b != curb) { curb = b; const float* mp = mod + (size_t)b * NMOD + (size_t)(3 * sub) * D;
#pragma unroll
            for (int j = 0; j < 4; ++j) { const f32x4 gg = *(const GAS f32x4*)(g + 256 * j + 4 * F.lane), sc = *(const GAS f32x4*)(mp + D + 256 * j + 4 * F.lane);
                gs[j] = gg * (sc + 1.0f); sh[j] = *(const GAS f32x4*)(mp + 256 * j + 4 * F.lane); } }
        const float* xrow = (row < MP ? xa : xb) + (size_t)row * D;
        const GAS f32x4* xr = (const GAS f32x4*)xrow + F.lane;
        f32x4 v[4]; float s = 0.f;
#pragma unroll
        for (int j = 0; j < 4; ++j) { v[j] = xr[64 * j]; s += (v[j].x * v[j].x + v[j].y * v[j].y) + (v[j].z * v[j].z + v[j].w * v[j].w); }
        const float rs = __builtin_amdgcn_rsqf(wave_sum(s) * (1.f / D) + NORM_EPS);
        GAS u32x2* o8 = (GAS u32x2*)(out + (size_t)row * D) + F.lane;
#pragma unroll
        for (int j = 0; j < 4; ++j) { const f32x4 y = v[j] * rs * gs[j] + sh[j]; u32x2 w; w.x = cvtpk(y.x, y.y); w.y = cvtpk(y.z, y.w); o8[64 * j] = w; }
    }
}
__device__ __forceinline__ void final_norm_phase(Frame& F, const float* x, float* out, const float* g) {
    const int gw = F.vcu * NWAVES + F.wave, NGW = F.G * NWAVES;
    f32x4 gg[4];
#pragma unroll
    for (int j = 0; j < 4; ++j) gg[j] = *(const GAS f32x4*)(g + 256 * j + 4 * F.lane);
    for (int row = gw; row < M; row += NGW) {
        const GAS f32x4* xr = (const GAS f32x4*)(x + (size_t)row * D) + F.lane;
        f32x4 v[4]; float s = 0.f;
#pragma unroll
        for (int j = 0; j < 4; ++j) { v[j] = xr[64 * j]; s += (v[j].x * v[j].x + v[j].y * v[j].y) + (v[j].z * v[j].z + v[j].w * v[j].w); }
        const float rs = __builtin_amdgcn_rsqf(wave_sum(s) * (1.f / D) + NORM_EPS);
        GAS f32x4* o = (GAS f32x4*)(out + (size_t)row * D) + F.lane;
#pragma unroll
        for (int j = 0; j < 4; ++j) o[64 * j] = v[j] * rs * gg[j];
    }
}

constexpr int D1_STRIDE = 50432;
constexpr int T_KN = 0, T_QS = 8192, T_KNT = 16384, T_KGT = 24576, T_VT = 32768, T_XB = 40960, T_ARR = 49152;
__device__ __forceinline__ int launder(int x) { asm volatile("" : "+v"(x)); return x; }
__device__ __forceinline__ int launder_lane(int x) { asm volatile("" : "+v"(x)); __builtin_assume(x >= 0); __builtin_assume(x < 64); return x; }
__device__ __forceinline__ int tswz(int row, int ch) { return row * 128 + (((ch ^ row) & 7) << 4); }
__device__ __forceinline__ int tswz8(int row, int col0) { return tswz(row, col0 >> 3) + (col0 & 7) * 2; }

__device__ __forceinline__ void mm64(const LAS unsigned char* Aop, const LAS unsigned char* Bop, f32x4 (&acc)[4][4], int r, int kq) {
#pragma unroll
    for (int a = 0; a < 4; ++a)
#pragma unroll
        for (int b = 0; b < 4; ++b) acc[a][b] = (f32x4){0.f, 0.f, 0.f, 0.f};
#pragma unroll
    for (int ks = 0; ks < 2; ++ks) { bf16x8 af[4], bfr[4];
#pragma unroll
        for (int a = 0; a < 4; ++a) af[a] = *(const LAS bf16x8*)(Aop + tswz(16 * a + r, 4 * ks + kq));
#pragma unroll
        for (int b = 0; b < 4; ++b) bfr[b] = *(const LAS bf16x8*)(Bop + tswz(16 * b + r, 4 * ks + kq));
#pragma unroll
        for (int a = 0; a < 4; ++a)
#pragma unroll
            for (int b = 0; b < 4; ++b) acc[a][b] = __builtin_amdgcn_mfma_f32_16x16x32_bf16(af[a], bfr[b], acc[a][b], 0, 0, 0); }
}
__device__ __forceinline__ void mm64h(const LAS unsigned char* Aop, const LAS unsigned char* Bop, f32x4 (&acc)[4][2], int b0, int r, int kq) {
#pragma unroll
    for (int a = 0; a < 4; ++a)
#pragma unroll
        for (int b = 0; b < 2; ++b) acc[a][b] = (f32x4){0.f, 0.f, 0.f, 0.f};
#pragma unroll
    for (int ks = 0; ks < 2; ++ks) { bf16x8 af[4], bfr[2];
#pragma unroll
        for (int a = 0; a < 4; ++a) af[a] = *(const LAS bf16x8*)(Aop + tswz(16 * a + r, 4 * ks + kq));
#pragma unroll
        for (int b = 0; b < 2; ++b) bfr[b] = *(const LAS bf16x8*)(Bop + tswz(16 * (b0 + b) + r, 4 * ks + kq));
#pragma unroll
        for (int a = 0; a < 4; ++a)
#pragma unroll
            for (int b = 0; b < 2; ++b) acc[a][b] = __builtin_amdgcn_mfma_f32_16x16x32_bf16(af[a], bfr[b], acc[a][b], 0, 0, 0); }
}
__device__ __forceinline__ void st_tile8(LAS unsigned char* tile, int row, int col0, const f32x4 v) { u32x2 w; w.x = cvtpk(v[0], v[1]); w.y = cvtpk(v[2], v[3]); *(LAS u32x2*)(tile + tswz8(row, col0)) = w; }

struct DeltaPtrs {
    const bf16* proj; const float* abg; const float* conv_w; const float* A_log; const float* dt_bias; const float* state_qkv;
    float* o_pqkv; float* o_sqkv; bf16* mch; bf16* mcl; float* nc; bf16* qe; float* ol;
};

template <int WHICH  , int HALF>
__device__ __forceinline__ void d1_conv(const DeltaPtrs& P, int ci, int h, LAS unsigned char* wl, int lane) {
    lane = launder_lane(lane);
    const int tq = lane >> 3, cg = lane & 7, r0 = ci * 64, colp = WHICH * 512 + h * 64 + 8 * cg, tb = 32 * HALF + 4 * tq;
    const bool samp = ci >= 256; const int c = samp ? 0 : (ci & 63); const bool lastc = samp || c == 63;
    float w[4][8];
#pragma unroll
    for (int t = 0; t < 4; ++t) { const f32x4 w0 = *(const GAS f32x4*)(P.conv_w + t * 1536 + colp), w1 = *(const GAS f32x4*)(P.conv_w + t * 1536 + colp + 4);
        w[t][0] = w0[0]; w[t][1] = w0[1]; w[t][2] = w0[2]; w[t][3] = w0[3]; w[t][4] = w1[0]; w[t][5] = w1[1]; w[t][6] = w1[2]; w[t][7] = w1[3]; }
    float win[4][8]; float o[4][8];
#pragma unroll
    for (int i = 0; i < 7; ++i) {
        const int trel = tb - 3 + i; float (&x)[8] = win[i & 3];
        if (HALF == 1 || trel >= 0 || (!samp && c > 0)) { const v4u raw = *(const GAS v4u*)(P.proj + (size_t)(r0 + trel) * PROJW + colp);
            x[0] = bflo(raw.x); x[1] = bfhi(raw.x); x[2] = bflo(raw.y); x[3] = bfhi(raw.y); x[4] = bflo(raw.z); x[5] = bfhi(raw.z); x[6] = bflo(raw.w); x[7] = bfhi(raw.w); }
        else if (samp) { const float* sp = P.state_qkv + ((size_t)(ci - 256) * 3 + (trel + 3)) * 1536 + colp; const f32x4 s0 = *(const GAS f32x4*)sp, s1 = *(const GAS f32x4*)(sp + 4);
            x[0] = s0[0]; x[1] = s0[1]; x[2] = s0[2]; x[3] = s0[3]; x[4] = s1[0]; x[5] = s1[1]; x[6] = s1[2]; x[7] = s1[3]; }
        else {
#pragma unroll
            for (int j = 0; j < 8; ++j) x[j] = 0.f; }
        if (HALF == 1 && lastc && i >= 4 && tq == 7) {
            float* op = (samp ? P.o_sqkv + ((size_t)(ci - 256) * 3 + (i - 4)) * 1536 : P.o_pqkv + ((size_t)(ci >> 6) * 3 + (i - 4)) * 1536) + colp;
            *(GAS f32x4*)op = (f32x4){x[0], x[1], x[2], x[3]}; *(GAS f32x4*)(op + 4) = (f32x4){x[4], x[5], x[6], x[7]}; }
        if (i >= 3) { const int oi = i - 3;
#pragma unroll
            for (int j = 0; j < 8; ++j) { const float y = w[0][j] * win[(i + 1) & 3][j] + w[1][j] * win[(i + 2) & 3][j] + w[2][j] * win[(i + 3) & 3][j] + w[3][j] * win[i & 3][j]; o[oi][j] = silu(y); } }
    }
    if (WHICH < 2) {
#pragma unroll
        for (int i = 0; i < 4; ++i) { float ss = 0.f;
#pragma unroll
            for (int j = 0; j < 8; ++j) ss += o[i][j] * o[i][j];
            ss += __shfl_xor(ss, 1); ss += __shfl_xor(ss, 2); ss += __shfl_xor(ss, 4);
            const float rn = __builtin_amdgcn_rsqf(ss + 1e-6f) * (WHICH == 0 ? 0.125f : 1.0f);
#pragma unroll
            for (int j = 0; j < 8; ++j) o[i][j] *= rn; }
    }
    if (WHICH < 2) {
        LAS unsigned char* tile = wl + (WHICH == 0 ? T_QS : T_KN);
#pragma unroll
        for (int i = 0; i < 4; ++i) { v4u pk; pk.x = cvtpk(o[i][0], o[i][1]); pk.y = cvtpk(o[i][2], o[i][3]); pk.z = cvtpk(o[i][4], o[i][5]); pk.w = cvtpk(o[i][6], o[i][7]);
            *(LAS v4u*)(tile + tswz(tb + i, cg)) = pk; }
    }
    if (WHICH >= 1) {
        LAS unsigned char* tile = wl + (WHICH == 1 ? T_KNT : T_VT);
#pragma unroll
        for (int j = 0; j < 8; ++j) { u32x2 pk; pk.x = cvtpk(o[0][j], o[1][j]); pk.y = cvtpk(o[2][j], o[3][j]); *(LAS u32x2*)(tile + tswz8(8 * cg + j, tb)) = pk; }
    }
    if (WHICH == 1) {
        const f32x4 g0 = *(const LAS f32x4*)((const LAS float*)(wl + T_ARR) + 128 + tb);
#pragma unroll
        for (int j = 0; j < 8; ++j) { u32x2 pk; pk.x = cvtpk(o[0][j] * g0[0], o[1][j] * g0[1]); pk.y = cvtpk(o[2][j] * g0[2], o[3][j] * g0[3]); *(LAS u32x2*)(wl + T_KGT + tswz8(8 * cg + j, tb)) = pk; }
    }
}

__device__ __forceinline__ void d1_item(const DeltaPtrs& P, int item, LAS unsigned char* wl, int lane) {
    lane = launder_lane(lane);
    const int ci = item >> 3, h = item & 7, r0 = ci * 64; int r = lane & 15, kq = lane >> 4;
    LAS float* aG = (LAS float*)(wl + T_ARR); LAS float* aB = aG + 64; LAS float* aGam = aG + 128; LAS float* aE = aG + 192; LAS float* aBG = aG + 256;
    float gam_end;
    {
        const float a = P.abg[(size_t)(r0 + lane) * 16 + h], bt = P.abg[(size_t)(r0 + lane) * 16 + 8 + h];
        const float g = -fexp(P.A_log[h]) * softplus(a + P.dt_bias[h]);
        const float beta = __builtin_amdgcn_rcpf(1.0f + fexp(-bt));
        float G = g;
#pragma unroll
        for (int o = 1; o < 64; o <<= 1) { const float y = __shfl_up(G, o); if (lane >= o) G += y; }
        const float Gend = __shfl(G, 63);
        const float gam = fexp(G);
        aG[lane] = G; aB[lane] = beta; aGam[lane] = gam; aE[lane] = fexp(Gend - G); aBG[lane] = beta * gam;
        gam_end = fexp(Gend);
    }
    LDS_WAIT();
    d1_conv<1, 0>(P, ci, h, wl, lane); d1_conv<1, 1>(P, ci, h, wl, lane);
    d1_conv<0, 0>(P, ci, h, wl, lane); d1_conv<0, 1>(P, ci, h, wl, lane);
    d1_conv<2, 0>(P, ci, h, wl, lane); d1_conv<2, 1>(P, ci, h, wl, lane);
    LDS_WAIT();
#if defined(D1_STAGE) && D1_STAGE <= 1
    return;
#endif
    f32x4 acc[4][4];
    u32x2 q2[4][4];
    {
        float Gt[4], Bt[4]; f32x4 Gs[4];
#pragma unroll
        for (int b = 0; b < 4; ++b) { Gt[b] = aG[16 * b + r]; Bt[b] = aB[16 * b + r]; }
#pragma unroll
        for (int a = 0; a < 4; ++a) Gs[a] = *(const LAS f32x4*)(aG + 16 * a + 4 * kq);
        mm64(wl + T_KN, wl + T_KN, acc, r, kq);
        f32x4 Am[4][4];
#pragma unroll
        for (int a = 0; a < 4; ++a)
#pragma unroll
            for (int b = 0; b < 4; ++b)
#pragma unroll
                for (int i = 0; i < 4; ++i) { const int s = 16 * a + 4 * kq + i, t = 16 * b + r; Am[a][b][i] = (s < t) ? Bt[b] * acc[a][b][i] * fexp(fminf(Gt[b] - Gs[a][i], 0.f)) : 0.f; }
        mm64(wl + T_KN, wl + T_QS, acc, r, kq);
#pragma unroll
        for (int a = 0; a < 4; ++a)
#pragma unroll
            for (int b = 0; b < 4; ++b) { f32x4 v;
#pragma unroll
                for (int i = 0; i < 4; ++i) { const int s = 16 * a + 4 * kq + i, t = 16 * b + r; v[i] = (s <= t) ? acc[a][b][i] * fexp(fminf(Gt[b] - Gs[a][i], 0.f)) : 0.f; }
                st_tile8(wl + T_XB, 16 * b + r, 16 * a + 4 * kq, v);
                q2[a][b] = *(const LAS u32x2*)(wl + T_QS + tswz8(16 * b + r, 16 * a + 4 * kq)); }
        LDS_WAIT();
        LAS float* Al = (LAS float*)(wl + T_KN);
#pragma unroll
        for (int a = 0; a < 4; ++a)
#pragma unroll
            for (int b = 0; b < 4; ++b) *(LAS f32x4*)(Al + (16 * b + r) * 64 + 16 * a + 4 * kq) = Am[a][b];
    }
    LDS_WAIT();
#if defined(D1_STAGE) && D1_STAGE <= 2
    *(GAS u32x2*)(P.qe + (size_t)item * 4096 + lane * 4) = q2[lane & 3][1];
    return;
#endif
    {
        const LAS float* Al = (const LAS float*)(wl + T_KN);
        float T[64];
        T[0] = (launder(lane) == 0) ? 1.0f : 0.f;
        const int ll = launder(lane);
#pragma unroll
        for (int t = 1; t < 64; ++t) { float v = (ll == t) ? 1.0f : 0.f;
#pragma unroll
            for (int s4 = 0; s4 < (t + 3) / 4; ++s4) { const f32x4 a4 = *(const LAS f32x4*)(Al + t * 64 + 4 * s4);
#pragma unroll
                for (int i = 0; i < 4; ++i) if (4 * s4 + i < t) v -= a4[i] * T[4 * s4 + i]; }
            asm volatile("" : "+v"(v) :: "memory"); T[t] = v; }
        LDS_WAIT();
        const float bl = aB[lane];
#pragma unroll
        for (int ch = 0; ch < 8; ++ch) { float tb[8];
#pragma unroll
            for (int j = 0; j < 8; ++j) tb[j] = T[8 * ch + j] * bl;
            v4u pk; pk.x = cvtpk(tb[0], tb[1]); pk.y = cvtpk(tb[2], tb[3]); pk.z = cvtpk(tb[4], tb[5]); pk.w = cvtpk(tb[6], tb[7]);
            *(LAS v4u*)(wl + T_KN + tswz(lane, ch)) = pk;
            const f32x4 e0 = *(const LAS f32x4*)(aE + 8 * ch), e1 = *(const LAS f32x4*)(aE + 8 * ch + 4);
            pk.x = cvtpk(tb[0] * e0[0], tb[1] * e0[1]); pk.y = cvtpk(tb[2] * e0[2], tb[3] * e0[3]); pk.z = cvtpk(tb[4] * e1[0], tb[5] * e1[1]); pk.w = cvtpk(tb[6] * e1[2], tb[7] * e1[3]);
            *(LAS v4u*)(wl + T_QS + tswz(lane, ch)) = pk; }
    }
    const size_t ib = (size_t)item * 4096;
#if defined(D1_STAGE) && D1_STAGE <= 3
    *(GAS u32x2*)(P.qe + ib + lane * 4) = q2[lane & 3][1];
    return;
#endif
    f32x4 ah[4][2];
#pragma unroll
    for (int b0 = 0; b0 < 4; b0 += 2) { mm64h(wl + T_KN, wl + T_XB, ah, b0, r, kq);
#pragma unroll
        for (int a = 0; a < 4; ++a)
#pragma unroll
            for (int b = 0; b < 2; ++b) st_tile8(wl + T_XB, 16 * (b0 + b) + r, 16 * a + 4 * kq, ah[a][b]); }
    asm volatile("" ::: "memory");
#pragma unroll
    for (int b0 = 0; b0 < 4; b0 += 2) { mm64h(wl + T_KGT, wl + T_XB, ah, b0, r, kq);
#pragma unroll
        for (int b = 0; b < 2; ++b) { const float gt = aGam[16 * (b0 + b) + r];
#pragma unroll
            for (int a = 0; a < 4; ++a) { const u32x2 qq = q2[a][b0 + b];
                u32x2 o2; o2.x = cvtpk(gt * bflo(qq.x) - ah[a][b][0], gt * bfhi(qq.x) - ah[a][b][1]); o2.y = cvtpk(gt * bflo(qq.y) - ah[a][b][2], gt * bfhi(qq.y) - ah[a][b][3]);
                *(GAS u32x2*)(P.qe + ib + (size_t)(16 * (b0 + b) + r) * 64 + 16 * a + 4 * kq) = o2; } } }
#if defined(D1_STAGE) && D1_STAGE <= 4
    return;
#endif
    asm volatile("" ::: "memory");
#pragma unroll
    for (int b0 = 0; b0 < 4; b0 += 2) { mm64h(wl + T_VT, wl + T_XB, ah, b0, r, kq);
#pragma unroll
        for (int a = 0; a < 4; ++a)
#pragma unroll
            for (int b = 0; b < 2; ++b) *(GAS f32x4*)(P.ol + ib + (size_t)((a * 4 + b0 + b) * 64 + lane) * 4) = ah[a][b]; }
    asm volatile("" ::: "memory");
#pragma unroll
    for (int b0 = 0; b0 < 4; b0 += 2) { mm64h(wl + T_QS, wl + T_KNT, ah, b0, r, kq);
#pragma unroll
        for (int a = 0; a < 4; ++a)
#pragma unroll
            for (int b = 0; b < 2; ++b) st_tile8(wl + T_XB, 16 * (b0 + b) + r, 16 * a + 4 * kq, ah[a][b]); }
    asm volatile("" ::: "memory");
#pragma unroll
    for (int b0 = 0; b0 < 4; b0 += 2) { mm64h(wl + T_KGT, wl + T_XB, ah, b0, r, kq);
#pragma unroll
        for (int a = 0; a < 4; ++a)
#pragma unroll
            for (int b = 0; b < 2; ++b) { float m[4], lo[4];
#pragma unroll
                for (int i = 0; i < 4; ++i) m[i] = ((16 * a + 4 * kq + i) == (16 * (b0 + b) + r) ? gam_end : 0.f) - ah[a][b][i];
                u32x2 hi2; hi2.x = cvtpk(m[0], m[1]); hi2.y = cvtpk(m[2], m[3]);
                lo[0] = m[0] - bflo(hi2.x); lo[1] = m[1] - bfhi(hi2.x); lo[2] = m[2] - bflo(hi2.y); lo[3] = m[3] - bfhi(hi2.y);
                u32x2 lo2; lo2.x = cvtpk(lo[0], lo[1]); lo2.y = cvtpk(lo[2], lo[3]);
                const size_t off = ib + (size_t)(16 * (b0 + b) + r) * 64 + 32 * (a >> 1) + 8 * kq + 4 * (a & 1);
                *(GAS u32x2*)(P.mch + off) = hi2; *(GAS u32x2*)(P.mcl + off) = lo2; } }
    asm volatile("" ::: "memory");
#pragma unroll
    for (int b0 = 0; b0 < 4; b0 += 2) { mm64h(wl + T_XB, wl + T_VT, ah, b0, r, kq);
#pragma unroll
        for (int a = 0; a < 4; ++a)
#pragma unroll
            for (int b = 0; b < 2; ++b) *(GAS f32x4*)(P.nc + ib + (size_t)(((b0 + b) * 4 + a) * 64 + lane) * 4) = ah[a][b]; }
    LDS_WAIT();
}

struct ScanOps { bf16x8 Ah[4][2], Al[4][2]; f32x4 N[4]; };
__device__ __forceinline__ void scan_load(ScanOps& o, const bf16* mch, const bf16* mcl, const float* nc, size_t ib, int j, int lane) {
    const int r = lane & 15, kq = lane >> 4;
#pragma unroll
    for (int m = 0; m < 4; ++m) {
#pragma unroll
        for (int ks = 0; ks < 2; ++ks) { const size_t off = ib + (size_t)(16 * m + r) * 64 + 32 * ks + 8 * kq; o.Ah[m][ks] = *(const GAS bf16x8*)(mch + off); o.Al[m][ks] = *(const GAS bf16x8*)(mcl + off); }
        o.N[m] = *(const GAS f32x4*)(nc + ib + (size_t)((j * 4 + m) * 64 + lane) * 4); }
}
__device__ __forceinline__ void scan_step(f32x4 (&S)[4], const ScanOps& o, u32x2 (&hi)[4]) {
    u32x2 lo[4];
#pragma unroll
    for (int m = 0; m < 4; ++m) { hi[m].x = cvtpk(S[m][0], S[m][1]); hi[m].y = cvtpk(S[m][2], S[m][3]);
        lo[m].x = cvtpk(S[m][0] - bflo(hi[m].x), S[m][1] - bfhi(hi[m].x)); lo[m].y = cvtpk(S[m][2] - bflo(hi[m].y), S[m][3] - bfhi(hi[m].y)); }
    bf16x8 Bh[2], Bl[2];
#pragma unroll
    for (int ks = 0; ks < 2; ++ks) { v4u t; t.x = hi[2 * ks].x; t.y = hi[2 * ks].y; t.z = hi[2 * ks + 1].x; t.w = hi[2 * ks + 1].y; Bh[ks] = __builtin_bit_cast(bf16x8, t);
        t.x = lo[2 * ks].x; t.y = lo[2 * ks].y; t.z = lo[2 * ks + 1].x; t.w = lo[2 * ks + 1].y; Bl[ks] = __builtin_bit_cast(bf16x8, t); }
#pragma unroll
    for (int m = 0; m < 4; ++m) { f32x4 n = o.N[m];
#pragma unroll
        for (int ks = 0; ks < 2; ++ks) { n = __builtin_amdgcn_mfma_f32_16x16x32_bf16(o.Ah[m][ks], Bh[ks], n, 0, 0, 0); n = __builtin_amdgcn_mfma_f32_16x16x32_bf16(o.Ah[m][ks], Bl[ks], n, 0, 0, 0);
            n = __builtin_amdgcn_mfma_f32_16x16x32_bf16(o.Al[m][ks], Bh[ks], n, 0, 0, 0); }
        S[m] = n; }
}
__device__ __forceinline__ void d2_prompt(const bf16* mch, const bf16* mcl, const float* nc, bf16* st, float* o_pdelta, int b, int h, int j, int lane) {
    const int r = lane & 15, kq = lane >> 4;
    f32x4 S[4];
#pragma unroll
    for (int m = 0; m < 4; ++m) S[m] = (f32x4){0.f, 0.f, 0.f, 0.f};
    ScanOps cur, nxt;
    scan_load(cur, mch, mcl, nc, (size_t)((b * 64) * 8 + h) * 4096, j, lane);
    for (int c = 0; c < 64; ++c) {
        const size_t ib = (size_t)((b * 64 + c) * 8 + h) * 4096;
        if (c + 1 < 64) scan_load(nxt, mch, mcl, nc, (size_t)((b * 64 + c + 1) * 8 + h) * 4096, j, lane);
        u32x2 hi[4];
        scan_step(S, cur, hi);
#pragma unroll
        for (int m = 0; m < 4; ++m) *(GAS u32x2*)(st + ib + (size_t)(16 * j + r) * 64 + 16 * m + 4 * kq) = hi[m];
        cur = nxt;
    }
    float* op = o_pdelta + (size_t)(b * 8 + h) * 4096;
#pragma unroll
    for (int m = 0; m < 4; ++m)
#pragma unroll
        for (int i = 0; i < 4; ++i) op[(16 * m + 4 * kq + i) * 64 + 16 * j + r] = S[m][i];
}
__device__ __forceinline__ void d2_sample(const bf16* mch, const bf16* mcl, const float* nc, const float* s0, float* o_sdelta, int bs, int h, int j, int lane) {
    const int r = lane & 15, kq = lane >> 4;
    const float* sp = s0 + (size_t)(bs * 8 + h) * 4096;
    f32x4 S[4];
#pragma unroll
    for (int m = 0; m < 4; ++m)
#pragma unroll
        for (int i = 0; i < 4; ++i) S[m][i] = sp[(16 * m + 4 * kq + i) * 64 + 16 * j + r];
    ScanOps cur; scan_load(cur, mch, mcl, nc, (size_t)((256 + bs) * 8 + h) * 4096, j, lane);
    u32x2 hi[4]; scan_step(S, cur, hi);
    float* op = o_sdelta + (size_t)(bs * 8 + h) * 4096;
#pragma unroll
    for (int m = 0; m < 4; ++m)
#pragma unroll
        for (int i = 0; i < 4; ++i) op[(16 * m + 4 * kq + i) * 64 + 16 * j + r] = S[m][i];
}
__device__ __forceinline__ void sc_item(const bf16* proj, const float* w_sc, const float* state_sc, bf16* cat, float* o_psc, float* o_ssc, int it, int lane) {
    const int row0 = it * 16, ch = 8 * lane;
    const bool samp = row0 >= MP; const int t0 = samp ? ((row0 - MP) & (DSEQ - 1)) : (row0 & (SEQ - 1)); const int bsq = samp ? ((row0 - MP) >> 6) : (row0 >> 12);
    float w[3][8];
#pragma unroll
    for (int t = 0; t < 3; ++t) { const f32x4 w0 = *(const GAS f32x4*)(w_sc + t * 512 + ch), w1 = *(const GAS f32x4*)(w_sc + t * 512 + ch + 4);
        w[t][0] = w0[0]; w[t][1] = w0[1]; w[t][2] = w0[2]; w[t][3] = w0[3]; w[t][4] = w1[0]; w[t][5] = w1[1]; w[t][6] = w1[2]; w[t][7] = w1[3]; }
    float p[3][8];
#pragma unroll
    for (int i = -2; i < 16; ++i) {
        float (&x)[8] = p[(i + 3) % 3];
        float sb[8];
        if (i >= 0 || t0 > 0) { const bf16* pr = proj + (size_t)(row0 + i) * PROJW + ch;
            const v4u c4 = *(const GAS v4u*)(pr + 2560), x4 = *(const GAS v4u*)(pr + 3072);
            x[0] = bflo(c4.x) * bflo(x4.x); x[1] = bfhi(c4.x) * bfhi(x4.x); x[2] = bflo(c4.y) * bflo(x4.y); x[3] = bfhi(c4.y) * bfhi(x4.y);
            x[4] = bflo(c4.z) * bflo(x4.z); x[5] = bfhi(c4.z) * bfhi(x4.z); x[6] = bflo(c4.w) * bflo(x4.w); x[7] = bfhi(c4.w) * bfhi(x4.w);
            if (i >= 0) { const v4u b4 = *(const GAS v4u*)(pr + 2048);
                sb[0] = bflo(b4.x); sb[1] = bfhi(b4.x); sb[2] = bflo(b4.y); sb[3] = bfhi(b4.y); sb[4] = bflo(b4.z); sb[5] = bfhi(b4.z); sb[6] = bflo(b4.w); sb[7] = bfhi(b4.w); }
        } else if (samp) { const float* sp = state_sc + ((size_t)bsq * 2 + (i + 2)) * 512 + ch; const f32x4 s0 = *(const GAS f32x4*)sp, s1 = *(const GAS f32x4*)(sp + 4);
            x[0] = s0[0]; x[1] = s0[1]; x[2] = s0[2]; x[3] = s0[3]; x[4] = s1[0]; x[5] = s1[1]; x[6] = s1[2]; x[7] = s1[3]; }
        else {
#pragma unroll
            for (int j = 0; j < 8; ++j) x[j] = 0.f; }
        if (i >= 0) {
            float y[8];
#pragma unroll
            for (int j = 0; j < 8; ++j) y[j] = sb[j] * (w[0][j] * p[(i + 1) % 3][j] + w[1][j] * p[(i + 2) % 3][j] + w[2][j] * x[j]);
            v4u o; o.x = cvtpk(y[0], y[1]); o.y = cvtpk(y[2], y[3]); o.z = cvtpk(y[4], y[5]); o.w = cvtpk(y[6], y[7]);
            *(GAS v4u*)(cat + (size_t)(row0 + i) * D + 512 + ch) = o;
            if (i >= 14 && t0 == (samp ? DSEQ : SEQ) - 16) { float* op = (samp ? o_ssc : o_psc) + ((size_t)bsq * 2 + (i - 14)) * 512 + ch;
                *(GAS f32x4*)op = (f32x4){x[0], x[1], x[2], x[3]}; *(GAS f32x4*)(op + 4) = (f32x4){x[4], x[5], x[6], x[7]}; }
        }
    }
}

__device__ __forceinline__ void d3_item(const bf16* qe, const float* ol, const bf16* st, const float* s0, const bf16* proj, const float* dn_g, bf16* cat, int item, int lane) {
    const int ci = item >> 3, h = item & 7, r0 = ci * 64, r = lane & 15, kq = lane >> 4;
    const bool samp = ci >= 256; const size_t ib = (size_t)item * 4096;
    f32x4 acc[4][4];
#pragma unroll
    for (int a = 0; a < 4; ++a)
#pragma unroll
        for (int b = 0; b < 4; ++b) acc[a][b] = *(const GAS f32x4*)(ol + ib + (size_t)((a * 4 + b) * 64 + lane) * 4);
#pragma unroll
    for (int ks = 0; ks < 2; ++ks) { bf16x8 af[4], bfr[4];
        if (!samp) {
#pragma unroll
            for (int a = 0; a < 4; ++a) af[a] = *(const GAS bf16x8*)(st + ib + (size_t)(16 * a + r) * 64 + 32 * ks + 8 * kq);
        } else { const float* sp = s0 + (size_t)((ci - 256) * 8 + h) * 4096 + (size_t)(32 * ks + 8 * kq) * 64;
#pragma unroll
            for (int a = 0; a < 4; ++a) { const float* q = sp + 16 * a + r; v4u t; t.x = cvtpk(q[0], q[64]); t.y = cvtpk(q[128], q[192]); t.z = cvtpk(q[256], q[320]); t.w = cvtpk(q[384], q[448]); af[a] = __builtin_bit_cast(bf16x8, t); } }
#pragma unroll
        for (int b = 0; b < 4; ++b) bfr[b] = *(const GAS bf16x8*)(qe + ib + (size_t)(16 * b + r) * 64 + 32 * ks + 8 * kq);
#pragma unroll
        for (int a = 0; a < 4; ++a)
#pragma unroll
            for (int b = 0; b < 4; ++b) acc[a][b] = __builtin_amdgcn_mfma_f32_16x16x32_bf16(af[a], bfr[b], acc[a][b], 0, 0, 0); }
    f32x4 gq[4];
#pragma unroll
    for (int a = 0; a < 4; ++a) gq[a] = *(const GAS f32x4*)(dn_g + 16 * a + 4 * kq);
#pragma unroll
    for (int b = 0; b < 4; ++b) { float ss = 0.f;
#pragma unroll
        for (int a = 0; a < 4; ++a) ss += (acc[a][b][0] * acc[a][b][0] + acc[a][b][1] * acc[a][b][1]) + (acc[a][b][2] * acc[a][b][2] + acc[a][b][3] * acc[a][b][3]);
        ss += __shfl_xor(ss, 16); ss += __shfl_xor(ss, 32);
        const float rs = __builtin_amdgcn_rsqf(ss * (1.f / 64.f) + NORM_EPS);
        const size_t row = (size_t)(r0 + 16 * b + r);
#pragma unroll
        for (int a = 0; a < 4; ++a) { const u32x2 z2 = *(const GAS u32x2*)(proj + row * PROJW + 1536 + h * 64 + 16 * a + 4 * kq);
            u32x2 o2; o2.x = cvtpk(acc[a][b][0] * rs * gq[a][0] * silu(bflo(z2.x)), acc[a][b][1] * rs * gq[a][1] * silu(bfhi(z2.x)));
            o2.y = cvtpk(acc[a][b][2] * rs * gq[a][2] * silu(bflo(z2.y)), acc[a][b][3] * rs * gq[a][3] * silu(bfhi(z2.y)));
            *(GAS u32x2*)(cat + row * D + h * 64 + 16 * a + 4 * kq) = o2; } }
}

struct AttnPtrs { const bf16* Q; const bf16* K; const bf16* V; const float* ck; const float* cv; bf16* O; };
__device__ __forceinline__ void attn_item(const AttnPtrs& P, int item, LAS unsigned char* vt, int lane) {
    lane = launder_lane(lane);
    const int r = lane & 15, kq = lane >> 4;
    const bool samp = item >= NB_P * 128 * NH_SB;
    int seq, h, qt2;
    if (!samp) { h = item & 15; qt2 = (item >> 4) & 127; seq = item >> 11; } else { const int e = item - NB_P * 128 * NH_SB; h = e & 15; qt2 = (e >> 4) & 1; seq = e >> 5; }
    const int qt = qt2 >> 1, qoff = 32 * (qt2 & 1);
    const int rowq0 = (samp ? MP + 64 * seq : seq * SEQ + 64 * qt) + qoff;
    const int ntiles = samp ? 1 + PAST / 64 : qt + 1;
    const size_t hc = (size_t)h * 64;
    float R[2] = {0.f, 0.f};
    f32x4 O[4][2];
#pragma unroll
    for (int a = 0; a < 4; ++a)
#pragma unroll
        for (int b = 0; b < 2; ++b) O[a][b] = (f32x4){0.f, 0.f, 0.f, 0.f};
    for (int step = 0; step < ntiles; ++step) {
        const bool diag = step == 0;
        bf16x8 ak[4][2];
        if (!samp || diag) {
            const int krow0 = samp ? MP + 64 * seq : seq * SEQ + 64 * (qt - step);
#pragma unroll
            for (int a = 0; a < 4; ++a)
#pragma unroll
                for (int ks = 0; ks < 2; ++ks) ak[a][ks] = *(const GAS bf16x8*)(P.K + (size_t)(krow0 + 16 * a + r) * D + hc + 32 * ks + 8 * kq);
#pragma unroll
            for (int i = 0; i < 8; ++i) { const int row = 8 * i + (lane >> 3), ch = lane & 7; *(LAS v4u*)(vt + tswz(row, ch)) = *(const GAS v4u*)(P.V + (size_t)(krow0 + row) * D + hc + 8 * ch); }
        } else {
            const size_t base = ((size_t)(seq * NH_SB + h) * PAST + (size_t)(PAST - 64 * step)) * 64;
#pragma unroll
            for (int a = 0; a < 4; ++a)
#pragma unroll
                for (int ks = 0; ks < 2; ++ks) { const float* p = P.ck + base + (size_t)(16 * a + r) * 64 + 32 * ks + 8 * kq; const f32x4 x0 = *(const GAS f32x4*)p, x1 = *(const GAS f32x4*)(p + 4);
                    v4u t; t.x = cvtpk(x0[0], x0[1]); t.y = cvtpk(x0[2], x0[3]); t.z = cvtpk(x1[0], x1[1]); t.w = cvtpk(x1[2], x1[3]); ak[a][ks] = __builtin_bit_cast(bf16x8, t); }
#pragma unroll
            for (int i = 0; i < 8; ++i) { const int row = 8 * i + (lane >> 3), ch = lane & 7; const float* p = P.cv + base + (size_t)row * 64 + 8 * ch; const f32x4 x0 = *(const GAS f32x4*)p, x1 = *(const GAS f32x4*)(p + 4);
                v4u t; t.x = cvtpk(x0[0], x0[1]); t.y = cvtpk(x0[2], x0[3]); t.z = cvtpk(x1[0], x1[1]); t.w = cvtpk(x1[2], x1[3]); *(LAS v4u*)(vt + tswz(row, ch)) = t; }
        }
        asm volatile("" ::: "memory");
        bf16x8 bw[2][2];
#pragma unroll
        for (int b = 0; b < 2; ++b) {
            const bf16x8 q0 = *(const GAS bf16x8*)(P.Q + (size_t)(rowq0 + 16 * b + r) * D + hc + 8 * kq), q1 = *(const GAS bf16x8*)(P.Q + (size_t)(rowq0 + 16 * b + r) * D + hc + 32 + 8 * kq);
            f32x4 z[4], L[4]; float p[4], inc[4], tot[4];
#pragma unroll
            for (int a = 0; a < 4; ++a) { z[a] = (f32x4){0.f, 0.f, 0.f, 0.f}; z[a] = __builtin_amdgcn_mfma_f32_16x16x32_bf16(ak[a][0], q0, z[a], 0, 0, 0); z[a] = __builtin_amdgcn_mfma_f32_16x16x32_bf16(ak[a][1], q1, z[a], 0, 0, 0); }
#pragma unroll
            for (int a = 0; a < 4; ++a) {
#pragma unroll
                for (int i = 0; i < 4; ++i) { const bool vis = !diag || (16 * a + 4 * kq + i) < (qoff + 16 * b + r); const float sp = softplus(z[a][i]); L[a][i] = vis ? -sp : 0.f; z[a][i] = vis ? z[a][i] - sp : -1e30f; }
                p[a] = (L[a][0] + L[a][1]) + (L[a][2] + L[a][3]); inc[a] = p[a];
                float y = __shfl_down(inc[a], 16); if (kq < 3) inc[a] += y;
                y = __shfl_down(inc[a], 32); if (kq < 2) inc[a] += y;
                tot[a] = __shfl(inc[a], r); }
            float asuf = R[b];
            f32x4 w[4];
#pragma unroll
            for (int a = 3; a >= 0; --a) { const float base = asuf + (inc[a] - p[a]);
                const float l3 = base, l2 = l3 + L[a][3], l1 = l2 + L[a][2], l0 = l1 + L[a][1];
                w[a][0] = fexp(z[a][0] + l0); w[a][1] = fexp(z[a][1] + l1); w[a][2] = fexp(z[a][2] + l2); w[a][3] = fexp(z[a][3] + l3);
                asuf += tot[a]; }
            R[b] = asuf;
#pragma unroll
            for (int ks = 0; ks < 2; ++ks) { v4u t; t.x = cvtpk(w[2 * ks][0], w[2 * ks][1]); t.y = cvtpk(w[2 * ks][2], w[2 * ks][3]); t.z = cvtpk(w[2 * ks + 1][0], w[2 * ks + 1][1]); t.w = cvtpk(w[2 * ks + 1][2], w[2 * ks + 1][3]);
                bw[ks][b] = __builtin_bit_cast(bf16x8, t); }
        }
        asm volatile("" ::: "memory");
#pragma unroll
        for (int ks = 0; ks < 2; ++ks)
#pragma unroll
            for (int a = 0; a < 4; ++a) { const int d = 16 * a + r; unsigned short e[8];
#pragma unroll
                for (int jj = 0; jj < 8; ++jj) { const int s = 16 * (2 * ks + (jj >> 2)) + 4 * kq + (jj & 3); e[jj] = *(const LAS unsigned short*)(vt + tswz(s, d >> 3) + (d & 7) * 2); }
                v4u t; t.x = (unsigned)e[0] | ((unsigned)e[1] << 16); t.y = (unsigned)e[2] | ((unsigned)e[3] << 16); t.z = (unsigned)e[4] | ((unsigned)e[5] << 16); t.w = (unsigned)e[6] | ((unsigned)e[7] << 16);
                const bf16x8 av = __builtin_bit_cast(bf16x8, t);
#pragma unroll
                for (int b = 0; b < 2; ++b) O[a][b] = __builtin_amdgcn_mfma_f32_16x16x32_bf16(av, bw[ks][b], O[a][b], 0, 0, 0); }
        const bool done = (R[0] < -104.f) && (R[1] < -104.f);
        if (__all(done)) break;
    }
#pragma unroll
    for (int b = 0; b < 2; ++b)
#pragma unroll
        for (int a = 0; a < 4; ++a) { u32x2 o2; o2.x = cvtpk(O[a][b][0], O[a][b][1]); o2.y = cvtpk(O[a][b][2], O[a][b][3]);
            *(GAS u32x2*)(P.O + (size_t)(rowq0 + 16 * b + r) * D + hc + 16 * a + 4 * kq) = o2; }
    LDS_WAIT();
}

struct Args { const float* in[24]; float* out; unsigned char* ws; int ph_lo, ph_hi; };
constexpr int N_PHASES = 24;
#ifndef MK_CUTS
#define MK_CUTS 0
#endif

__global__ void __launch_bounds__(NWAVES * 64, 2) hybrid_fwd(Args args) {
    extern __shared__ __attribute__((aligned(16))) unsigned char lds_raw[];
    Frame F;
    F.lds = (LAS unsigned char*)lds_raw;
    F.tid = threadIdx.x; F.lane = F.tid & 63; F.wave = __builtin_amdgcn_readfirstlane(F.tid >> 6);
    F.G = gridDim.x; { const int bx = blockIdx.x; F.vcu = (F.G % 8 == 0) ? (bx % 8) * (F.G / 8) + bx / 8 : bx; }
#pragma unroll
    for (int i = 0; i < 24; ++i) F.in[i] = args.in[i];
    F.out = args.out; F.ws = args.ws;
    unsigned char* ws = args.ws;
    volatile LAS unsigned* MISC = (volatile LAS unsigned*)(F.lds + MISC_OFF);
    static_assert(3 * D1_STRIDE <= MISC_OFF && RING_BYTES <= MISC_OFF && 48 * COND_STRIDE + 48 * 64 * 4 <= MISC_OFF, "phase scratch below the barrier's LDS words");
    if (F.tid < 32) MISC[F.tid] = 0u;
    __syncthreads();
    XcdBarrier bar = xcd_barrier_post((unsigned*)(ws + WS_CTL) + CW_BAR + (MK_CUTS ? args.ph_lo / (MK_CUTS ? MK_CUTS : 1) : 0) * XCD_BAR_WORDS, MISC + 8);
    const int lo = args.ph_lo, hi = args.ph_hi;
#ifndef PH_MASK
#define PH_MASK 0xffffffu
#endif
#define IN(k) (((PH_MASK >> (k)) & 1u) && lo <= (k) && (k) < hi)
#define SEAM(k) do { if (IN(k) && IN((k) + 1)) xcd_barrier(bar); } while (0)

    float* mods = (float*)(ws + WS_MODS);
    float* X = (float*)(ws + WS_X);
    bf16* HH = (bf16*)(ws + WS_HH); bf16* ACT = (bf16*)(ws + WS_ACT); bf16* PROJ = (bf16*)(ws + WS_PROJ); float* ABG = (float*)(ws + WS_ABG); bf16* CAT = (bf16*)(ws + WS_CAT);
    bf16* QB = (bf16*)(ws + WS_Q); bf16* KB = (bf16*)(ws + WS_K); bf16* VB = (bf16*)(ws + WS_V);
    const float* x_p = F.in[0]; const float* x_s_off = F.in[1] - (size_t)MP * D;
    const float* norm_g = F.in[9];
    float* out = F.out;

#define NORM_PHASE(k, xa, xb, l, sub) do { if (IN(k)) { norm_phase(F, xa, xb, HH, norm_g + (size_t)((l) * 3 + (sub)) * D, mods + (size_t)(l) * NBATCH * NMOD, sub); } SEAM(k); } while (0)
#define FFN_UP_PHASE(k, idx) do { if (IN(k)) { pg8::Gemm g{HH, (const bf16*)(ws + WS_WFI) + (size_t)(idx) * FF2 * D, M, FF2, D}; pg8::StaticOrder S; S.init(M, FF2, F.G, (int)blockIdx.x); \
        pg8::EpiSwiglu E{ACT}; pg8::gemm_phase<pg8::EpiSwiglu, pg8::StaticOrder, true, true>(F.lds, g, S, E); } SEAM(k); } while (0)
#define FFN_DOWN_PHASE(k, idx, xa, xb, l, sub) do { if (IN(k)) { pg8::Gemm g{ACT, (const bf16*)(ws + WS_WFO) + (size_t)(idx) * D * FF, M, D, FF}; pg8::StaticOrder S; S.init(M, D, F.G, (int)blockIdx.x); \
        pg8::EpiResid E{xa, xb, X, mods + (size_t)(l) * NBATCH * NMOD + (size_t)(3 * (sub) + 2) * D, 0.5f}; pg8::gemm_phase<pg8::EpiResid, pg8::StaticOrder, true, true>(F.lds, g, S, E); } SEAM(k); } while (0)

    if (IN(0)) { p0_mods(F, F.in[2], F.in[3], F.in[10], F.in[11], mods); p0_weights(F); }
    SEAM(0);
    NORM_PHASE(1, x_p, x_s_off, 0, 0);
    FFN_UP_PHASE(2, 0);
    FFN_DOWN_PHASE(3, 0, x_p, x_s_off, 0, 0);
    NORM_PHASE(4, X, X, 0, 1);
    if (IN(5)) { pg8::Gemm g{HH, (const bf16*)(ws + WS_WABI), M, ABN, D}; pg8::StaticOrder S; S.init(M, ABN, F.G, (int)blockIdx.x);
        pg8::EpiAB E{PROJ, ABG}; pg8::gemm_phase<pg8::EpiAB, pg8::StaticOrder, true, true>(F.lds, g, S, E); }
    SEAM(5);
    if (IN(6)) {
        if (F.wave < 3) { DeltaPtrs P{PROJ, ABG, F.in[15], F.in[16], F.in[17], F.in[5], out + O_PQKV, out + O_SQKV, (bf16*)(ws + WS_MCH), (bf16*)(ws + WS_MCL), (float*)(ws + WS_NC), (bf16*)(ws + WS_QE), (float*)(ws + WS_OL)};
            for (int item = blockIdx.x * 3 + F.wave; item < 288 * 8; item += F.G * 3) d1_item(P, item, F.lds + F.wave * D1_STRIDE, F.lane); }
    }
    SEAM(6);
    if (IN(7)) {
        const bf16* mch = (const bf16*)(ws + WS_MCH); const bf16* mcl = (const bf16*)(ws + WS_MCL); const float* nc = (const float*)(ws + WS_NC);
        const int bx = blockIdx.x;
        if (bx < 128 && F.wave == 0) { const int chain = bx >> 2; d2_prompt(mch, mcl, nc, (bf16*)(ws + WS_ST), out + O_PDELTA, chain >> 3, chain & 7, bx & 3, F.lane); }
        else { const int nfree = F.G * 8 - 128; const int id = bx < 128 ? bx * 7 + (F.wave - 1) : 128 * 7 + (bx - 128) * 8 + F.wave;
            for (int t = id; t < 1024 + M / 16; t += nfree) {
                if (t < 1024) d2_sample(mch, mcl, nc, F.in[4], out + O_SDELTA, t >> 5, (t >> 2) & 7, t & 3, F.lane);
                else sc_item(PROJ, F.in[19], F.in[6], CAT, out + O_PSC, out + O_SSC, t - 1024, F.lane); } }
    }
    SEAM(7);
    if (IN(8)) { const int gw = F.vcu * NWAVES + F.wave, NGW = F.G * NWAVES;
        for (int item = gw; item < 288 * 8; item += NGW) d3_item((const bf16*)(ws + WS_QE), (const float*)(ws + WS_OL), (const bf16*)(ws + WS_ST), F.in[4], PROJ, F.in[18], CAT, item, F.lane); }
    SEAM(8);
    if (IN(9)) { pg8::Gemm g{CAT, (const bf16*)(ws + WS_WABO), M, D, D}; pg8::StaticOrder S; S.init(M, D, F.G, (int)blockIdx.x);
        pg8::EpiResid E{X, X, X, mods + (size_t)(3 * 1 + 2) * D, 1.0f}; pg8::gemm_phase<pg8::EpiResid, pg8::StaticOrder, true, true>(F.lds, g, S, E); }
    SEAM(9);
    NORM_PHASE(10, X, X, 0, 2);
    FFN_UP_PHASE(11, 1);
    FFN_DOWN_PHASE(12, 1, X, X, 0, 2);
    NORM_PHASE(13, X, X, 1, 0);
    FFN_UP_PHASE(14, 2);
    FFN_DOWN_PHASE(15, 2, X, X, 1, 0);
    NORM_PHASE(16, X, X, 1, 1);
    if (IN(17)) { pg8::Gemm g{HH, (const bf16*)(ws + WS_WQKV), M, 3 * D, D}; pg8::StaticOrder S; S.init(M, 3 * D, F.G, (int)blockIdx.x);
        pg8::EpiQKV E{QB, (size_t)(WS_K - WS_Q) / 2, out + O_PK, out + O_SK, O_PV - O_PK, O_SV - O_SK}; pg8::gemm_phase<pg8::EpiQKV, pg8::StaticOrder, true, true>(F.lds, g, S, E); }
    SEAM(17);
    if (IN(18)) { const int gw = F.vcu * NWAVES + F.wave, NGW = F.G * NWAVES; AttnPtrs P{QB, KB, VB, F.in[7], F.in[8], CAT};
        for (int item = gw; item < (NB_P * 128 + NB_S * 2) * NH_SB; item += NGW) attn_item(P, item, F.lds + F.wave * 8192, F.lane); }
    SEAM(18);
    if (IN(19)) { pg8::Gemm g{CAT, (const bf16*)(ws + WS_WSBO), M, D, D}; pg8::StaticOrder S; S.init(M, D, F.G, (int)blockIdx.x);
        pg8::EpiResid E{X, X, X, mods + (size_t)NBATCH * NMOD + (size_t)(3 * 1 + 2) * D, 1.0f}; pg8::gemm_phase<pg8::EpiResid, pg8::StaticOrder, true, true>(F.lds, g, S, E); }
    SEAM(19);
    NORM_PHASE(20, X, X, 1, 2);
    FFN_UP_PHASE(21, 3);
    FFN_DOWN_PHASE(22, 3, X, X, 1, 2);
    if (IN(23)) final_norm_phase(F, X, out + O_YP, F.in[23]);
#undef IN
#undef SEAM
}

extern "C" void kernel_launch(void* const* d_in, const int* in_sizes, int n_in, void* d_out, int out_size, void* d_ws, size_t ws_size, hipStream_t stream) {
    static int grid = 0;
    if (grid == 0) {
        if (n_in != 24 || (size_t)out_size != O_END || ws_size < WS_END) { fprintf(stderr, "kernel_launch: unexpected shapes (n_in %d, out %d, ws %zu); nothing launched\n", n_in, out_size, ws_size); grid = -1; return; }
        int dev = 0, cus = 0, per_cu = 0;
        if (hipGetDevice(&dev) != hipSuccess || hipDeviceGetAttribute(&cus, hipDeviceAttributeMultiprocessorCount, dev) != hipSuccess) { grid = -1; return; }
        if (hipFuncSetAttribute((const void*)hybrid_fwd, hipFuncAttributeMaxDynamicSharedMemorySize, LDS_BYTES) != hipSuccess) { fprintf(stderr, "kernel_launch: hipFuncSetAttribute failed\n"); grid = -1; return; }
        if (hipOccupancyMaxActiveBlocksPerMultiprocessor(&per_cu, (const void*)hybrid_fwd, NWAVES * 64, LDS_BYTES) != hipSuccess || per_cu < 1) { fprintf(stderr, "kernel_launch: occupancy query reports %d workgroups per CU\n", per_cu); }
        (void)hipGetLastError();
        grid = cus;
    }
    if (grid < 0) return;
    if (hipMemsetAsync((char*)d_ws + WS_CTL, 0, CTL_ZERO_BYTES, stream) != hipSuccess) return;
    Args a{};
    for (int i = 0; i < 24; ++i) a.in[i] = (const float*)d_in[i];
    a.out = (float*)d_out; a.ws = (unsigned char*)d_ws;
#if MK_CUTS == 0
    a.ph_lo = 0; a.ph_hi = N_PHASES;
    hipLaunchKernelGGL(hybrid_fwd, dim3(grid), dim3(NWAVES * 64), LDS_BYTES, stream, a);
#else
    for (int p = 0; p < N_PHASES; p += MK_CUTS) { a.ph_lo = p; a.ph_hi = p + MK_CUTS < N_PHASES ? p + MK_CUTS : N_PHASES;
        hipLaunchKernelGGL(hybrid_fwd, dim3(grid), dim3(NWAVES * 64), LDS_BYTES, stream, a); }
#endif
}
```
